# Optimizing an MI355X kernel written in HIP

```python
import jax, jax.numpy as jnp
from jax import lax
import numpy as np

D_MODEL = 1024
BATCH = 4
SEQ = 4096
DEPTH = 4
DEC_BATCH = 32
DEC_SEQ = 8
PAST_LEN = 8192
PAGE_SIZE = 128

N_A = DEPTH // 2
N_B = DEPTH - N_A
CONV_WIDTH = 31
N_HEADS = 16
HEAD_DIM = D_MODEL // N_HEADS
WINDOWS = (128, 512, 2048)
DILATIONS = (1, 4, 16)
N_GROUPS = len(WINDOWS)
BLK = 128
D_FF = (8 * D_MODEL + 3 * 256 - 1) // (3 * 256) * 256
ROPE_THETA = 10000.0
EPS = 1e-6
SCALE = HEAD_DIM ** -0.5

kernel_name = 'yoco_conformer_dilated_swa_decoder'


def rms_norm(x, g):
    xf = x.astype(jnp.float32)
    y = xf * lax.rsqrt(jnp.mean(xf * xf, axis=-1, keepdims=True) + EPS)
    return (y * g.astype(jnp.float32)).astype(x.dtype)


def layer_norm(x, g, b):
    xf = x.astype(jnp.float32)
    mu = jnp.mean(xf, axis=-1, keepdims=True)
    xc = xf - mu
    y = xc * lax.rsqrt(jnp.mean(xc * xc, axis=-1, keepdims=True) + EPS)
    return (y * g.astype(jnp.float32) + b.astype(jnp.float32)).astype(x.dtype)


def rotary(x, pos):
    half = HEAD_DIM // 2
    inv = ROPE_THETA ** (-jnp.arange(half, dtype=jnp.float32) / half)
    ang = pos.astype(jnp.float32)[:, None] * inv[None, :]
    shp = (1, pos.shape[0]) + (1,) * (x.ndim - 3) + (half,)
    cos = jnp.cos(ang).reshape(shp)
    sin = jnp.sin(ang).reshape(shp)
    xf = x.astype(jnp.float32)
    x1, x2 = xf[..., :half], xf[..., half:]
    return jnp.concatenate([x1 * cos - x2 * sin, x2 * cos + x1 * sin], axis=-1).astype(x.dtype)


def conv_module(x, prev, norm_g, w_in, b_in, w_dw, b_dw, ln_g, ln_b, w_out, b_out):
    u = rms_norm(x, norm_g)
    a = u @ w_in + b_in
    glu = a[..., :D_MODEL] * jax.nn.sigmoid(a[..., D_MODEL:])
    ext = jnp.concatenate([prev.astype(glu.dtype), glu], axis=1)
    c = lax.conv_general_dilated(ext, w_dw[:, None, :].astype(ext.dtype), window_strides=(1,),
                                 padding='VALID', dimension_numbers=('NWC', 'WIO', 'NWC'),
                                 feature_group_count=D_MODEL) + b_dw
    h = jax.nn.silu(layer_norm(c, ln_g, ln_b))
    return h @ w_out + b_out, ext[:, -(CONV_WIDTH - 1):]


def swiglu(x, g, w_gate_up, w_down):
    gu = rms_norm(x, g) @ w_gate_up
    return (jax.nn.silu(gu[..., :D_FF]) * gu[..., D_FF:]) @ w_down


def shared_kv(s, pos, kv_norm, w_kv, k_norm):
    B, S, _ = s.shape
    kv = (rms_norm(s, kv_norm) @ w_kv).reshape(B, S, N_GROUPS, 2, N_HEADS, HEAD_DIM)
    k = rotary(rms_norm(kv[:, :, :, 0], k_norm[None, None, :, None, :]), pos)
    v = kv[:, :, :, 1]
    return k, v


def queries(x, pos, b_norm, w_q, q_norm):
    B, S, _ = x.shape
    q = (rms_norm(x, b_norm) @ w_q).reshape(B, S, N_GROUPS, N_HEADS, HEAD_DIM)
    return rotary(rms_norm(q, q_norm[None, None, :, None, :]), pos)


def to_blocks(x, r):
    B, S, H, hd = x.shape
    span = r * BLK
    Sp = -(-S // span) * span
    L = Sp // r
    x = jnp.pad(x, ((0, 0), (0, Sp - S), (0, 0), (0, 0)))
    x = x.reshape(B, L, r, H, hd).transpose(0, 2, 1, 3, 4)
    return x.reshape(B, r, L // BLK, BLK, H, hd)


def band_keys(k, v, r):
    def with_prev(xb):
        prev = jnp.concatenate([jnp.zeros_like(xb[:, :, :1]), xb[:, :, :-1]], axis=2)
        return jnp.concatenate([prev, xb], axis=3)
    return with_prev(to_blocks(k, r)), with_prev(to_blocks(v, r))


def band_attention(q, kb2, vb2, r, n_strided):
    B, S, H, hd = q.shape
    nb = kb2.shape[2]
    L = nb * BLK
    Sp = L * r
    qb = to_blocks(q, r)
    s = jnp.einsum('brnqhd,brnkhd->brnhqk', qb.astype(jnp.float32), kb2.astype(jnp.float32)) * SCALE
    qi = jnp.arange(BLK)[:, None]
    ki = jnp.arange(2 * BLK)[None, :]
    dist = BLK + qi - ki
    band = (dist >= 0) & (dist <= n_strided)
    after_start = (jnp.arange(nb)[:, None, None] > 0) | (ki[None] >= BLK)
    mask = band[None] & after_start
    s = jnp.where(mask[None, None, :, None], s, -jnp.inf)
    lse = jax.nn.logsumexp(s, axis=-1)
    p = jnp.exp(s - lse[..., None])
    o = jnp.einsum('brnhqk,brnkhd->brnqhd', p, vb2.astype(jnp.float32))
    o = o.reshape(B, r, L, H, hd).transpose(0, 2, 1, 3, 4).reshape(B, Sp, H, hd)[:, :S]
    lse = lse.transpose(0, 1, 2, 4, 3).reshape(B, r, L, H).transpose(0, 2, 1, 3).reshape(B, Sp, H)[:, :S]
    return o, lse


def gather_keys(buf, k_new, v_new, r, n_strided):
    Lb = buf.shape[1]
    T = k_new.shape[1]
    kall = jnp.concatenate([buf[:, :, 0].astype(k_new.dtype), k_new], axis=1)
    vall = jnp.concatenate([buf[:, :, 1].astype(v_new.dtype), v_new], axis=1)
    idx = Lb + jnp.arange(T)[:, None] - r * jnp.arange(n_strided + 1)[None, :]
    valid = idx >= 0
    idx = jnp.maximum(idx, 0)
    kg = kall[:, idx]
    vg = vall[:, idx]
    new_buf = jnp.stack([kall[:, -Lb:], vall[:, -Lb:]], axis=2)
    return (kg, vg, valid), new_buf


def gathered_attention(q, kg, vg, valid):
    s = jnp.einsum('bthd,btjhd->bhtj', q.astype(jnp.float32), kg.astype(jnp.float32)) * SCALE
    s = jnp.where(valid[None, None], s, -jnp.inf)
    lse = jax.nn.logsumexp(s, axis=-1)
    p = jnp.exp(s - lse[..., None])
    o = jnp.einsum('bhtj,btjhd->bthd', p, vg.astype(jnp.float32))
    return o, lse.transpose(0, 2, 1)


def merge_groups(outs, lses, w_o, dtype):
    o = jnp.stack(outs, axis=0)
    w = jax.nn.softmax(jnp.stack(lses, axis=0), axis=0)
    o = jnp.sum(w[..., None] * o, axis=0)
    B, S = o.shape[:2]
    return o.reshape(B, S, N_HEADS * HEAD_DIM).astype(dtype) @ w_o


def run_trunk(x, pos, conv_prev, kv_bufs, p):
    conv_states = []
    keyside, new_bufs = [], []
    for layer in range(DEPTH):
        if layer < N_A:
            h, st = conv_module(x, conv_prev[layer], p['a_norm'][layer], p['a_w_in'][layer], p['a_b_in'][layer],
                                p['a_w_dw'][layer], p['a_b_dw'][layer], p['a_ln_g'][layer], p['a_ln_b'][layer],
                                p['a_w_out'][layer], p['a_b_out'][layer])
            x = x + h
            conv_states.append(st)
        else:
            if layer == N_A:
                k, v = shared_kv(x, pos, p['kv_norm'], p['w_kv'], p['k_norm'])
                for g in range(N_GROUPS):
                    r = DILATIONS[g]
                    if kv_bufs is None:
                        keyside.append(band_keys(k[:, :, g], v[:, :, g], r))
                        lg = min(WINDOWS[g], x.shape[1])
                        new_bufs.append(jnp.stack([k[:, -lg:, g], v[:, -lg:, g]], axis=2))
                    else:
                        ks, nbuf = gather_keys(kv_bufs[g], k[:, :, g], v[:, :, g], r, WINDOWS[g] // r)
                        keyside.append(ks)
                        new_bufs.append(nbuf)
            j = layer - N_A
            q = queries(x, pos, p['b_norm'][j], p['w_q'][j], p['q_norm'][j])
            outs, lses = [], []
            for g in range(N_GROUPS):
                r = DILATIONS[g]
                if kv_bufs is None:
                    o, l = band_attention(q[:, :, g], keyside[g][0], keyside[g][1], r, WINDOWS[g] // r)
                else:
                    o, l = gathered_attention(q[:, :, g], *keyside[g])
                outs.append(o)
                lses.append(l)
            x = x + merge_groups(outs, lses, p['w_o'][j], x.dtype)
        x = x + swiglu(x, p['ffn_norm'][layer], p['w_gate_up'][layer], p['w_down'][layer])
    return x, jnp.stack(conv_states, axis=0), new_bufs


def setup_inputs(seed: int = 0) -> dict:
    key = jax.random.key(seed)
    ks = jax.random.split(key, 32)
    f32 = jnp.float32

    def nrm(k, shape, scale):
        return scale * jax.random.normal(k, shape, f32)

    GH = N_GROUPS * N_HEADS * HEAD_DIM
    return {
        'x_prompt': nrm(ks[0], (BATCH, SEQ, D_MODEL), 1.0),
        'x_sample': nrm(ks[1], (DEC_BATCH, DEC_SEQ, D_MODEL), 1.0),
        'cache_conv': nrm(ks[2], (N_A, DEC_BATCH, CONV_WIDTH - 1, D_MODEL), 0.5),
        'cache_kv_w128': nrm(ks[3], (DEC_BATCH, min(WINDOWS[0], PAST_LEN), 2, N_HEADS, HEAD_DIM), 1.0),
        'cache_kv_w512': nrm(ks[4], (DEC_BATCH, min(WINDOWS[1], PAST_LEN), 2, N_HEADS, HEAD_DIM), 1.0),
        'cache_kv_w2048': nrm(ks[5], (DEC_BATCH, min(WINDOWS[2], PAST_LEN), 2, N_HEADS, HEAD_DIM), 1.0),
        'a_norm': 1.0 + nrm(ks[6], (N_A, D_MODEL), 0.05),
        'a_w_in': nrm(ks[7], (N_A, D_MODEL, 2 * D_MODEL), D_MODEL ** -0.5),
        'a_b_in': nrm(ks[8], (N_A, 2 * D_MODEL), 0.02),
        'a_w_dw': nrm(ks[9], (N_A, CONV_WIDTH, D_MODEL), CONV_WIDTH ** -0.5),
        'a_b_dw': nrm(ks[10], (N_A, D_MODEL), 0.02),
        'a_ln_g': 1.0 + nrm(ks[11], (N_A, D_MODEL), 0.05),
        'a_ln_b': nrm(ks[12], (N_A, D_MODEL), 0.02),
        'a_w_out': nrm(ks[13], (N_A, D_MODEL, D_MODEL), D_MODEL ** -0.5),
        'a_b_out': nrm(ks[14], (N_A, D_MODEL), 0.02),
        'kv_norm': 1.0 + nrm(ks[15], (D_MODEL,), 0.05),
        'w_kv': nrm(ks[16], (D_MODEL, 2 * GH), D_MODEL ** -0.5),
        'k_norm': 1.0 + nrm(ks[17], (N_GROUPS, HEAD_DIM), 0.05),
        'b_norm': 1.0 + nrm(ks[18], (N_B, D_MODEL), 0.05),
        'w_q': nrm(ks[19], (N_B, D_MODEL, GH), D_MODEL ** -0.5),
        'q_norm': 1.0 + nrm(ks[20], (N_B, N_GROUPS, HEAD_DIM), 0.05),
        'w_o': nrm(ks[21], (N_B, N_HEADS * HEAD_DIM, D_MODEL), (N_HEADS * HEAD_DIM) ** -0.5),
        'ffn_norm': 1.0 + nrm(ks[22], (DEPTH, D_MODEL), 0.05),
        'w_gate_up': nrm(ks[23], (DEPTH, D_MODEL, 2 * D_FF), D_MODEL ** -0.5),
        'w_down': nrm(ks[24], (DEPTH, D_FF, D_MODEL), D_FF ** -0.5),
    }


def reference(x_prompt, x_sample, cache_conv, cache_kv_w128, cache_kv_w512, cache_kv_w2048,
              a_norm, a_w_in, a_b_in, a_w_dw, a_b_dw, a_ln_g, a_ln_b, a_w_out, a_b_out,
              kv_norm, w_kv, k_norm, b_norm, w_q, q_norm, w_o, ffn_norm, w_gate_up, w_down):
    p = dict(a_norm=a_norm, a_w_in=a_w_in, a_b_in=a_b_in, a_w_dw=a_w_dw, a_b_dw=a_b_dw,
             a_ln_g=a_ln_g, a_ln_b=a_ln_b, a_w_out=a_w_out, a_b_out=a_b_out,
             kv_norm=kv_norm, w_kv=w_kv, k_norm=k_norm, b_norm=b_norm, w_q=w_q, q_norm=q_norm,
             w_o=w_o, ffn_norm=ffn_norm, w_gate_up=w_gate_up, w_down=w_down)
    B, S, _ = x_prompt.shape
    T = x_sample.shape[1]
    pos_prompt = jnp.arange(S, dtype=jnp.int32)
    pos_sample = PAST_LEN + jnp.arange(T, dtype=jnp.int32)
    conv_zero = jnp.zeros((N_A, B, CONV_WIDTH - 1, D_MODEL), x_prompt.dtype)
    y_prompt, conv_p, bufs_p = run_trunk(x_prompt, pos_prompt, conv_zero, None, p)
    y_sample, conv_s, bufs_s = run_trunk(x_sample, pos_sample, cache_conv,
                                         (cache_kv_w128, cache_kv_w512, cache_kv_w2048), p)
    return (y_prompt, y_sample, conv_p, conv_s, bufs_p[0], bufs_p[1], bufs_p[2], bufs_s[0], bufs_s[1], bufs_s[2])
```

```cpp
#include <hip/hip_runtime.h>
#include <hip/hip_cooperative_groups.h>
#include <cstdio>
#include <cstdint>
namespace cg = cooperative_groups;

#define PROBE_GU 1
#define PROBE_ASM 1
#define PROBE_QKV 1
#define PROBE_DN 0
#define PROBE_WIN 1
#define PROBE_MG 1
#define PROBE_APR 1
#define PROBE_AT 1
#define PROBE_CV 1
#define PROBE_PR 1
#ifndef ONE_LAUNCH
#define ONE_LAUNCH 1
#endif

#define LAS __attribute__((address_space(3)))
typedef unsigned short bf16_t;
typedef short bf16x8 __attribute__((ext_vector_type(8)));
typedef short s16x4 __attribute__((ext_vector_type(4)));
typedef float f32x2 __attribute__((ext_vector_type(2)));
typedef float f32x4 __attribute__((ext_vector_type(4)));
typedef float f32x16 __attribute__((ext_vector_type(16)));
typedef unsigned u32x2 __attribute__((ext_vector_type(2)));
typedef unsigned u32x4 __attribute__((ext_vector_type(4)));
typedef __bf16 bf16x2_t __attribute__((ext_vector_type(2)));

constexpr int D = 1024, SEQ = 4096, NBATCH = 4, MP = NBATCH * SEQ, DECB = 32, DECT = 8, MS = DECB * DECT, M = MP + MS;
constexpr int FF = 2816, GH = 3072, NPH = 23;
constexpr float EPS = 1e-6f;
constexpr float QSCALE = 0.125f * 1.4426950408889634f;
constexpr float LN2 = 0.6931471805599453f;

constexpr size_t O_Y = 0;
constexpr size_t O_CP = (size_t)M * D;
constexpr size_t O_CS = O_CP + (size_t)2 * 4 * 30 * D;
constexpr size_t O_KP0 = O_CS + (size_t)2 * 32 * 30 * D;
constexpr size_t O_KP1 = O_KP0 + (size_t)4 * 128 * 2048;
constexpr size_t O_KP2 = O_KP1 + (size_t)4 * 512 * 2048;
constexpr size_t O_KS0 = O_KP2 + (size_t)4 * 2048 * 2048;
constexpr size_t O_KS1 = O_KS0 + (size_t)32 * 128 * 2048;
constexpr size_t O_KS2 = O_KS1 + (size_t)32 * 512 * 2048;
constexpr size_t O_END = O_KS2 + (size_t)32 * 2048 * 2048;

constexpr size_t MiB = 1u << 20;
constexpr size_t WS_CTL = 0, CTL_BYTES = 1 * MiB, SS_OFF = 65536;
constexpr size_t WS_CS = 1 * MiB;
constexpr size_t WS_WIN = 3 * MiB, WS_WOUT = 11 * MiB, WS_WGU = 15 * MiB, WS_WDN = 59 * MiB, WS_WQKV = 81 * MiB, WS_WQ2 = 99 * MiB, WS_WO = 105 * MiB;
constexpr size_t WS_XB = 109 * MiB, WS_GLU = 142 * MiB, WS_HB = 175 * MiB, WS_ACT = 208 * MiB, WS_QB = 298 * MiB, WS_KB = 396 * MiB, WS_VB = 494 * MiB;
constexpr size_t WS_OG = 592 * MiB, WS_LSE = 690 * MiB, WS_KC = 694 * MiB, WS_END = 1036 * MiB;
constexpr size_t KC_OFF1 = (size_t)32 * 136 * 2048, KC_OFF2 = KC_OFF1 + (size_t)32 * 520 * 2048, KC_ELEMS = KC_OFF2 + (size_t)32 * 2056 * 2048;
static_assert(WS_KC + KC_ELEMS * 2 <= WS_END, "KC fits");
constexpr int LDS_BYTES = 135168;

struct Params { const float* in[25]; float* out; unsigned char* ws; int ph_lo, ph_hi; };

__device__ __forceinline__ unsigned pk2(float lo, float hi) { f32x2 v = {lo, hi}; bf16x2_t b = __builtin_convertvector(v, bf16x2_t); return __builtin_bit_cast(unsigned, b); }
__device__ __forceinline__ float bflo(unsigned u) { return __uint_as_float(u << 16); }
__device__ __forceinline__ float bfhi(unsigned u) { return __uint_as_float(u & 0xffff0000u); }
__device__ __forceinline__ float sigmoidf_(float x) { return __builtin_amdgcn_rcpf(1.f + __expf(-x)); }
__device__ __forceinline__ float wave_sum(float v) {
#pragma unroll
    for (int o = 1; o < 64; o <<= 1) v += __shfl_xor(v, o);
    return v;
}
template <int CTRL, int RM> __device__ __forceinline__ float dpp_f(float v) { return __int_as_float(__builtin_amdgcn_update_dpp(0, __float_as_int(v), CTRL, RM, 0xF, false)); }
__device__ __forceinline__ float wave_sum_dpp(float v) {
    v += dpp_f<0xB1, 0xF>(v);
    v += dpp_f<0x4E, 0xF>(v);
    v += dpp_f<0x141, 0xF>(v);
    v += dpp_f<0x140, 0xF>(v);
    v += dpp_f<0x142, 0xA>(v);
    v += dpp_f<0x143, 0xC>(v);
    return __int_as_float(__builtin_amdgcn_readlane(__float_as_int(v), 63));
}
template <int CTRL, int RM> __device__ __forceinline__ float dpp_keep(float v) { return __int_as_float(__builtin_amdgcn_update_dpp(__float_as_int(v), __float_as_int(v), CTRL, RM, 0xF, false)); }
__device__ __forceinline__ float wave_max_dpp(float v) {
    v = fmaxf(v, dpp_keep<0xB1, 0xF>(v)); v = fmaxf(v, dpp_keep<0x4E, 0xF>(v)); v = fmaxf(v, dpp_keep<0x141, 0xF>(v)); v = fmaxf(v, dpp_keep<0x140, 0xF>(v));
    v = fmaxf(v, dpp_keep<0x142, 0xA>(v)); v = fmaxf(v, dpp_keep<0x143, 0xC>(v));
    return __int_as_float(__builtin_amdgcn_readlane(__float_as_int(v), 63));
}
__device__ __forceinline__ float xrow16_sum(float x) {
    auto s = __builtin_amdgcn_permlane16_swap(__float_as_uint(x), __float_as_uint(x), false, false);
    x = __uint_as_float(s[0]) + __uint_as_float(s[1]);
    auto t = __builtin_amdgcn_permlane32_swap(__float_as_uint(x), __float_as_uint(x), false, false);
    return __uint_as_float(t[0]) + __uint_as_float(t[1]);
}
__device__ __forceinline__ float half_swap_sum(float x) { auto t = __builtin_amdgcn_permlane32_swap(__float_as_uint(x), __float_as_uint(x), false, false); return __uint_as_float(t[0]) + __uint_as_float(t[1]); }
__device__ __forceinline__ float half_swap_max(float x) { auto t = __builtin_amdgcn_permlane32_swap(__float_as_uint(x), __float_as_uint(x), false, false); return fmaxf(__uint_as_float(t[0]), __uint_as_float(t[1])); }
__device__ __forceinline__ float wave_max(float v) {
#pragma unroll
    for (int o = 1; o < 64; o <<= 1) v = fmaxf(v, __shfl_xor(v, o));
    return v;
}
__device__ __forceinline__ u32x4 pack8(f32x4 a, f32x4 b) { u32x4 w; w.x = pk2(a[0], a[1]); w.y = pk2(a[2], a[3]); w.z = pk2(b[0], b[1]); w.w = pk2(b[2], b[3]); return w; }

namespace pg8 {
constexpr int BM = 256, BK = 64, HALF = 128, HTB = HALF * BK * 2, NXCD = 8, WGM = 8;
__device__ __forceinline__ int lds_byte(int r, int c) { const int st = (r >> 4) * 2 + (c >> 5), rr = r & 15, cc = c & 31, ob = rr * 64 + cc * 2; return st * 1024 + (ob ^ (((ob >> 9) & 1) << 5)); }
__device__ __forceinline__ void stage_rc(int b, int& R, int& C) { const int st = b / 1024, sb = b % 1024, swz = sb ^ (((sb >> 9) & 1) << 5); R = (st >> 1) * 16 + swz / 64; C = (st & 1) * 32 + (swz % 64) / 2; }
__device__ __forceinline__ int perm32(int rho) { const int n = rho >> 4, i = rho & 15; return 8 * (i >> 2) + 4 * n + (i & 3); }
struct Unit { int pm, pn; };
struct Gemm { const bf16_t* A; const bf16_t* Bt; int M, N, K; };
struct StaticOrder {
    int nM, nN, nwg, G, c;
    __device__ void init(int M_, int N_, int G_, int c_) { nM = M_ / BM; nN = N_ / BM; nwg = nM * nN; G = G_; c = c_; }
    __device__ bool next(int i, Unit& u) const {
        if (c >= G) return false;
        const long L = (long)i * G + c; if (L >= nwg) return false;
        int wgid = (int)L; { const int q = nwg / NXCD, r = nwg % NXCD, xcd = wgid % NXCD, off = wgid / NXCD; wgid = (xcd < r ? xcd * (q + 1) : r * (q + 1) + (xcd - r) * q) + off; }
        const int nig = WGM * nN, gid = wgid / nig, fm = gid * WGM, gsz = (nM - fm) < WGM ? (nM - fm) : WGM;
        u.pm = fm + ((wgid % nig) % gsz); u.pn = (wgid % nig) / gsz; return true;
    }
};
template <class Epi>
__device__ __forceinline__ void gemm_phase(LAS unsigned char* lds, const Gemm g, const StaticOrder& S, const Epi& E) {
    const int tid = threadIdx.x, wid = __builtin_amdgcn_readfirstlane(tid >> 6), lane = tid & 63, wr = wid >> 2, wc = wid & 3, fr = lane & 15, fq = lane >> 4;
    const int K = g.K, nt = K / BK;
    unsigned voffA[2], voffB[2];
#pragma unroll
    for (int i = 0; i < 2; ++i) { int R, C; stage_rc(tid * 16 + i * 8192, R, C); const int Rb = (R & ~31) + perm32(R & 31);
        voffA[i] = (unsigned)(R * K + C) * 2u; voffB[i] = (unsigned)(Rb * K + C) * 2u; }
    const size_t kstep = (size_t)(BK * 2);
    const size_t hstep = (size_t)HALF * K * 2;
    const size_t tstep = 2 * hstep;
    const unsigned ldsw = (unsigned)wid * 1024u;
    const int aoff = lds_byte(wr * 64 + fr, fq * 8), boff = lds_byte(wc * 32 + fr, fq * 8);
#define PG8_SA(b, h) (((b) * 2 + (h)) * HTB)
#define PG8_SB(b, h) ((4 + (b) * 2 + (h)) * HTB)
#define PG8_STAGE(bufoff, gbase, voff) do { _Pragma("unroll") for (int _i = 0; _i < 2; ++_i) \
        __builtin_amdgcn_global_load_lds((const unsigned*)((const char*)(gbase) + (voff)[_i]), (LAS unsigned*)(lds + (bufoff) + ldsw + _i * 8192), 16, 0, 0); } while (0)
#define PG8_LDA(dst, b, h) do { _Pragma("unroll") for (int m = 0; m < 4; ++m) _Pragma("unroll") for (int k = 0; k < 2; ++k) dst[m][k] = *(const LAS bf16x8*)(lds + PG8_SA(b, h) + aoff + m * 2048 + k * 1024); } while (0)
#define PG8_LDB(dst, b, h) do { _Pragma("unroll") for (int n = 0; n < 2; ++n) _Pragma("unroll") for (int k = 0; k < 2; ++k) dst[n][k] = *(const LAS bf16x8*)(lds + PG8_SB(b, h) + boff + n * 2048 + k * 1024); } while (0)
#define PG8_MMA(ai, bj, At, Bt) do { __builtin_amdgcn_s_setprio(1); _Pragma("unroll") for (int m = 0; m < 4; ++m) _Pragma("unroll") for (int n = 0; n < 2; ++n) _Pragma("unroll") for (int k = 0; k < 2; ++k) \
        acc[ai][bj][m][n] = __builtin_amdgcn_mfma_f32_16x16x32_bf16(Bt[n][k], At[m][k], acc[ai][bj][m][n], 0, 0, 0); __builtin_amdgcn_s_setprio(0); } while (0)
#define PG8_WAIT_V(n) asm volatile("s_waitcnt vmcnt(" #n ")" ::: "memory")
#define PG8_WAIT_L(n) asm volatile("s_waitcnt lgkmcnt(" #n ")" ::: "memory")
#define PG8_BAR __builtin_amdgcn_s_barrier()
#define PG8_SCHED __builtin_amdgcn_sched_barrier(0)
    Unit cur, nxt; int ui = 0;
    if (!S.next(0, cur)) return;
    f32x4 acc[2][2][4][2];
#pragma unroll
    for (int a = 0; a < 2; ++a)
#pragma unroll
        for (int b = 0; b < 2; ++b)
#pragma unroll
            for (int m = 0; m < 4; ++m)
#pragma unroll
                for (int n = 0; n < 2; ++n) acc[a][b][m][n] = (f32x4){0.f, 0.f, 0.f, 0.f};
    bf16x8 At[4][2], B0[2][2], B1[2][2];
    const char* cA = (const char*)g.A + (size_t)cur.pm * tstep; const char* cB = (const char*)g.Bt + (size_t)cur.pn * tstep;
    PG8_STAGE(PG8_SB(0, 0), cB, voffB); PG8_STAGE(PG8_SB(0, 1), cB + hstep, voffB); PG8_STAGE(PG8_SA(0, 0), cA, voffA); PG8_STAGE(PG8_SA(0, 1), cA + hstep, voffA);
    if (wr == 1) PG8_BAR;
    PG8_WAIT_V(2); PG8_BAR;
    PG8_STAGE(PG8_SB(1, 0), cB + kstep, voffB); PG8_STAGE(PG8_SA(1, 0), cA + kstep, voffA); PG8_STAGE(PG8_SB(1, 1), cB + hstep + kstep, voffB);
    PG8_WAIT_V(6); PG8_BAR;
    for (;;) {
        const bool has_next = S.next(ui + 1, nxt);
        const char* nA = has_next ? (const char*)g.A + (size_t)nxt.pm * tstep : cA; const char* nB = has_next ? (const char*)g.Bt + (size_t)nxt.pn * tstep : cB;
        for (int t = 0; t < nt; t += 2) {
            const bool last = (t == nt - 2);
            const char* a1 = cA + (size_t)(t + 1) * kstep;
            const char* a2 = last ? nA : cA + (size_t)(t + 2) * kstep; const char* b2 = last ? nB : cB + (size_t)(t + 2) * kstep;
            const char* a3 = a2 + kstep; const char* b3 = b2 + kstep;
            PG8_LDB(B0, 0, 0); PG8_LDB(B1, 0, 1); PG8_SCHED; PG8_LDA(At, 0, 0); PG8_STAGE(PG8_SA(1, 1), a1 + hstep, voffA);
            PG8_WAIT_V(8); PG8_WAIT_L(0); PG8_BAR; PG8_MMA(0, 0, At, B0); PG8_MMA(0, 1, At, B1); PG8_BAR; PG8_SCHED;
            PG8_LDA(At, 0, 1); PG8_STAGE(PG8_SB(0, 0), b2, voffB); PG8_STAGE(PG8_SB(0, 1), b2 + hstep, voffB); PG8_STAGE(PG8_SA(0, 0), a2, voffA);
            PG8_WAIT_V(8); PG8_WAIT_L(0); PG8_BAR; PG8_MMA(1, 0, At, B0); PG8_MMA(1, 1, At, B1); PG8_BAR; PG8_SCHED;
            PG8_LDB(B0, 1, 0); PG8_LDB(B1, 1, 1); PG8_SCHED; PG8_LDA(At, 1, 0); PG8_STAGE(PG8_SA(0, 1), a2 + hstep, voffA);
            PG8_WAIT_V(8); PG8_WAIT_L(0); PG8_BAR; PG8_MMA(0, 0, At, B0); PG8_MMA(0, 1, At, B1); PG8_BAR; PG8_SCHED;
            PG8_LDA(At, 1, 1); PG8_STAGE(PG8_SB(1, 0), b3, voffB); PG8_STAGE(PG8_SB(1, 1), b3 + hstep, voffB); PG8_STAGE(PG8_SA(1, 0), a3, voffA);
            PG8_WAIT_V(8); PG8_WAIT_L(0); PG8_BAR; PG8_MMA(1, 0, At, B0); PG8_MMA(1, 1, At, B1); PG8_BAR; PG8_SCHED;
        }
        if (wr == 0) PG8_BAR;
        E(acc, cur, wr, wc, fr, fq);
        if (!has_next) break;
#pragma unroll
        for (int a = 0; a < 2; ++a)
#pragma unroll
            for (int b = 0; b < 2; ++b)
#pragma unroll
                for (int m = 0; m < 4; ++m)
#pragma unroll
                    for (int n = 0; n < 2; ++n) acc[a][b][m][n] = (f32x4){0.f, 0.f, 0.f, 0.f};
        cur = nxt; cA = nA; cB = nB; ++ui;
        if (wr == 1) PG8_BAR;
    }
    PG8_WAIT_V(0);
    PG8_BAR;
#undef PG8_SA
#undef PG8_SB
#undef PG8_STAGE
#undef PG8_LDA
#undef PG8_LDB
#undef PG8_MMA
#undef PG8_WAIT_V
#undef PG8_WAIT_L
#undef PG8_BAR
#undef PG8_SCHED
}
}
using pg8::Unit;

struct EpiGLU {
    bf16_t* G; const float* ss; const float* bias; float* cs_p; float* cs_s;
    __device__ __forceinline__ void operator()(const f32x4 (&acc)[2][2][4][2], const Unit& u, int wr, int wc, int fr, int fq) const {
#ifdef SKIP_EPIGLU
        return;
#endif
        const int ocol = u.pn * 128 + wc * 32 + fq * 8;
        f32x4 bv[2][2];
#pragma unroll
        for (int bj = 0; bj < 2; ++bj)
#pragma unroll
            for (int n = 0; n < 2; ++n) bv[bj][n] = *(const f32x4*)(bias + bj * D + ocol + 4 * n);
        float rsv[8];
#pragma unroll
        for (int q8 = 0; q8 < 8; ++q8) rsv[q8] = ss[u.pm * 256 + (q8 >> 2) * 128 + wr * 64 + (q8 & 3) * 16 + fr];
#pragma unroll
        for (int q8 = 0; q8 < 8; ++q8) rsv[q8] = rsqrtf(rsv[q8] * (1.f / D) + EPS);
#pragma unroll
        for (int ai = 0; ai < 2; ++ai)
#pragma unroll
            for (int m = 0; m < 4; ++m) {
                const int row = u.pm * 256 + ai * 128 + wr * 64 + m * 16 + fr;
                const float rs = rsv[ai * 4 + m];
                f32x4 o[2];
#pragma unroll
                for (int n = 0; n < 2; ++n) {
                    const f32x4 v = acc[ai][0][m][n] * rs + bv[0][n], gt = acc[ai][1][m][n] * rs + bv[1][n];
#pragma unroll
                    for (int j = 0; j < 4; ++j) o[n][j] = v[j] * sigmoidf_(gt[j]);
                }
                *(u32x4*)(G + (size_t)row * D + ocol) = pack8(o[0], o[1]);
                float* cs = nullptr;
                if (row < MP) { const int t = row & (SEQ - 1); if (t >= SEQ - 30) cs = cs_p + ((size_t)(row >> 12) * 30 + (t - (SEQ - 30))) * D; }
                else { const int rsr = row - MP; cs = cs_s + ((size_t)(rsr >> 3) * 30 + 22 + (rsr & 7)) * D; }
                if (cs) { *(f32x4*)(cs + ocol) = o[0]; *(f32x4*)(cs + ocol + 4) = o[1]; }
            }
    }
};
struct EpiRes {
    const float* xold_p; const float* xold_s; float* xnew; bf16_t* xb; const float* bias; float* ss_out;
    __device__ __forceinline__ void operator()(const f32x4 (&acc)[2][2][4][2], const Unit& u, int wr, int wc, int fr, int fq) const {
#ifdef SKIP_EPIRES
        return;
#endif
        const int col0 = u.pn * 256 + wc * 32 + fq * 8;
        f32x4 bv[2][2];
#pragma unroll
        for (int bj = 0; bj < 2; ++bj)
#pragma unroll
            for (int n = 0; n < 2; ++n) bv[bj][n] = bias ? *(const f32x4*)(bias + col0 + bj * 128 + 4 * n) : (f32x4){0.f, 0.f, 0.f, 0.f};
        f32x4 xc[2][2], xn[2][2];
        {
            const int row = u.pm * 256 + wr * 64 + fr;
            const float* xo = row < MP ? xold_p + (size_t)row * D : xold_s + (size_t)(row - MP) * D;
#pragma unroll
            for (int bj = 0; bj < 2; ++bj) { xc[bj][0] = *(const f32x4*)(xo + col0 + bj * 128); xc[bj][1] = *(const f32x4*)(xo + col0 + bj * 128 + 4); }
        }
#pragma unroll
        for (int q8 = 0; q8 < 8; ++q8) {
            const int ai = q8 >> 2, m = q8 & 3;
            const int row = u.pm * 256 + ai * 128 + wr * 64 + m * 16 + fr;
            if (q8 < 7) {
                const int rown = u.pm * 256 + ((q8 + 1) >> 2) * 128 + wr * 64 + ((q8 + 1) & 3) * 16 + fr;
                const float* xo = rown < MP ? xold_p + (size_t)rown * D : xold_s + (size_t)(rown - MP) * D;
#pragma unroll
                for (int bj = 0; bj < 2; ++bj) { xn[bj][0] = *(const f32x4*)(xo + col0 + bj * 128); xn[bj][1] = *(const f32x4*)(xo + col0 + bj * 128 + 4); }
            }
            float sq = 0.f;
#pragma unroll
            for (int bj = 0; bj < 2; ++bj) {
                const int c = col0 + bj * 128;
                const f32x4 x0 = xc[bj][0] + acc[ai][bj][m][0] + bv[bj][0], x1 = xc[bj][1] + acc[ai][bj][m][1] + bv[bj][1];
                *(f32x4*)(xnew + (size_t)row * D + c) = x0; *(f32x4*)(xnew + (size_t)row * D + c + 4) = x1;
                *(u32x4*)(xb + (size_t)row * D + c) = pack8(x0, x1);
#pragma unroll
                for (int j = 0; j < 4; ++j) sq += x0[j] * x0[j] + x1[j] * x1[j];
            }
            sq = xrow16_sum(sq);
            if (ss_out && fq == 0) atomicAdd(ss_out + row, sq);
#pragma unroll
            for (int bj = 0; bj < 2; ++bj) { xc[bj][0] = xn[bj][0]; xc[bj][1] = xn[bj][1]; }
        }
    }
};
struct EpiSwiGLU {
    bf16_t* A; const float* ss;
    __device__ __forceinline__ void operator()(const f32x4 (&acc)[2][2][4][2], const Unit& u, int wr, int wc, int fr, int fq) const {
#ifdef SKIP_EPISWIGLU
        return;
#endif
        const int ocol = u.pn * 128 + wc * 32 + fq * 8;
        float rsv[8];
#pragma unroll
        for (int q8 = 0; q8 < 8; ++q8) rsv[q8] = ss[u.pm * 256 + (q8 >> 2) * 128 + wr * 64 + (q8 & 3) * 16 + fr];
#pragma unroll
        for (int q8 = 0; q8 < 8; ++q8) rsv[q8] = rsqrtf(rsv[q8] * (1.f / D) + EPS);
#pragma unroll
        for (int ai = 0; ai < 2; ++ai)
#pragma unroll
            for (int m = 0; m < 4; ++m) {
                const int row = u.pm * 256 + ai * 128 + wr * 64 + m * 16 + fr;
                const float rs = rsv[ai * 4 + m];
                f32x4 o[2];
#pragma unroll
                for (int n = 0; n < 2; ++n) {
                    const f32x4 gt = acc[ai][0][m][n] * rs, up = acc[ai][1][m][n] * rs;
#pragma unroll
                    for (int j = 0; j < 4; ++j) o[n][j] = gt[j] * sigmoidf_(gt[j]) * up[j];
                }
                *(u32x4*)(A + (size_t)row * FF + ocol) = pack8(o[0], o[1]);
            }
    }
};
template <int J> struct EpiQKV {
    unsigned char* ws; const float* k_norm; const float* q_norm; float* out;
    __device__ __forceinline__ void operator()(const f32x4 (&acc)[2][2][4][2], const Unit& u, int wr, int wc, int fr, int fq) const {
#ifdef SKIP_EPIQKV
        return;
#endif
        const int pn = u.pn + (J == 0 ? 0 : 24);
        const float* ss = (const float*)(ws + WS_CTL + SS_OFF) + (size_t)(4 + 2 * J) * M;
        bf16_t* QB = (bf16_t*)(ws + WS_QB); bf16_t* KB = (bf16_t*)(ws + WS_KB); bf16_t* VB = (bf16_t*)(ws + WS_VB); const float* CS = (const float*)(ws + WS_CS);
        const bool is_q = pn >= 24;
        int g, kvsel = 0, hq;
        if (!is_q) { g = pn >> 3; kvsel = (pn >> 2) & 1; hq = pn & 3; } else { const int pq = pn - 24; g = pq >> 2; hq = pq & 3; }
        const int h = hq * 4 + wc, dlo = fq * 8;
        const bool do_norm = is_q || kvsel == 0;
        f32x4 gv[2][2];
#pragma unroll
        for (int bj = 0; bj < 2; ++bj)
#pragma unroll
            for (int n = 0; n < 2; ++n) gv[bj][n] = *(const f32x4*)((is_q ? q_norm : k_norm) + g * 64 + bj * 32 + dlo + 4 * n);
        bf16_t* dstb = (is_q ? QB : (kvsel ? VB : KB)) + g * 1024 + h * 64 + dlo;
        const int lg = 128 << (2 * g);
        float* kvp = out + (g == 0 ? O_KP0 : (g == 1 ? O_KP1 : O_KP2));
        float* kvs = out + (g == 0 ? O_KS0 : (g == 1 ? O_KS1 : O_KS2));
        float rsv[8];
#pragma unroll
        for (int q8 = 0; q8 < 8; ++q8) rsv[q8] = ss[u.pm * 256 + (q8 >> 2) * 128 + wr * 64 + (q8 & 3) * 16 + fr];
#pragma unroll
        for (int q8 = 0; q8 < 8; ++q8) rsv[q8] = rsqrtf(rsv[q8] * (1.f / D) + EPS);
        f32x4 cur[4], d16[4];
        {
            const int row0 = u.pm * 256 + wr * 64 + fr;
            const int pidx0 = row0 < MP ? (row0 & (SEQ - 1)) : SEQ + ((row0 - MP) & 7);
            const bool smp = u.pm * 256 >= MP;
#pragma unroll
            for (int q4 = 0; q4 < 4; ++q4) {
                cur[q4] = do_norm ? *((const f32x4*)(CS + ((size_t)pidx0 * 32 + dlo) * 2) + q4) : (f32x4){1.f, 0.f, 1.f, 0.f};
                d16[q4] = (do_norm && !smp) ? *((const f32x4*)(CS + ((size_t)16 * 32 + dlo) * 2) + q4) : (f32x4){1.f, 0.f, 1.f, 0.f};
            }
        }
#pragma unroll
        for (int ai = 0; ai < 2; ++ai) {
#pragma unroll
            for (int m = 0; m < 4; ++m) {
                const int row = u.pm * 256 + ai * 128 + wr * 64 + m * 16 + fr;
                const float rs = rsv[ai * 4 + m];
                f32x4 v[2][2];
#pragma unroll
                for (int bj = 0; bj < 2; ++bj)
#pragma unroll
                    for (int n = 0; n < 2; ++n) v[bj][n] = acc[ai][bj][m][n] * rs;
                if (do_norm) {
                    float sq = 0.f;
#pragma unroll
                    for (int bj = 0; bj < 2; ++bj)
#pragma unroll
                        for (int n = 0; n < 2; ++n)
#pragma unroll
                            for (int j = 0; j < 4; ++j) sq += v[bj][n][j] * v[bj][n][j];
                    sq = xrow16_sum(sq);
                    const float hr = rsqrtf(sq * (1.f / 64.f) + EPS);
                    const f32x4* csp = cur;
                    const float sc = is_q ? QSCALE : 1.f;
#pragma unroll
                    for (int n = 0; n < 2; ++n) {
                        const f32x4 y1 = v[0][n] * hr * gv[0][n], y2 = v[1][n] * hr * gv[1][n];
                        const f32x4 c01 = csp[2 * n], c23 = csp[2 * n + 1];
                        const float cs_[4] = {c01[0], c01[2], c23[0], c23[2]}, sn_[4] = {c01[1], c01[3], c23[1], c23[3]};
#pragma unroll
                        for (int j = 0; j < 4; ++j) { v[0][n][j] = (y1[j] * cs_[j] - y2[j] * sn_[j]) * sc; v[1][n][j] = (y2[j] * cs_[j] + y1[j] * sn_[j]) * sc; }
                    }
                }
                *(u32x4*)(dstb + (size_t)row * GH) = pack8(v[0][0], v[0][1]);
                *(u32x4*)(dstb + (size_t)row * GH + 32) = pack8(v[1][0], v[1][1]);
                if (!is_q) {
                    float* dst = nullptr;
                    if (row < MP) { const int t = row & (SEQ - 1), i = t - (SEQ - lg); if (i >= 0) dst = kvp + (((size_t)(row >> 12) * lg + i) * 2 + kvsel) * 1024 + h * 64 + dlo; }
                    else { const int rsr = row - MP; dst = kvs + (((size_t)(rsr >> 3) * lg + lg - 8 + (rsr & 7)) * 2 + kvsel) * 1024 + h * 64 + dlo;
                        bf16_t* kc = (bf16_t*)(ws + WS_KC) + (g == 0 ? 0 : (g == 1 ? KC_OFF1 : KC_OFF2)) + (((size_t)(rsr >> 3) * (lg + 8) + lg + (rsr & 7)) * 2 + kvsel) * 1024 + h * 64 + dlo;
                        *(u32x4*)kc = pack8(v[0][0], v[0][1]); *(u32x4*)(kc + 32) = pack8(v[1][0], v[1][1]); }
                    if (dst) { *(f32x4*)dst = v[0][0]; *(f32x4*)(dst + 4) = v[0][1]; *(f32x4*)(dst + 32) = v[1][0]; *(f32x4*)(dst + 36) = v[1][1]; }
                }
                if (do_norm && !(ai == 1 && m == 3)) {
#pragma unroll
                    for (int rep = 0; rep < ((m == 3) ? 5 : 1); ++rep)
#pragma unroll
                        for (int q4 = 0; q4 < 4; ++q4) { const f32x4 a = cur[q4], d = d16[q4]; cur[q4] = (f32x4){a[0] * d[0] - a[1] * d[1], a[1] * d[0] + a[0] * d[1], a[2] * d[2] - a[3] * d[3], a[3] * d[2] + a[2] * d[3]}; }
                }
            }
        }
    }
};

constexpr unsigned COPY_G0 = 32u * 120u * 512u, COPY_G1 = 32u * 504u * 512u, COPY_G2 = 32u * 2040u * 512u;
constexpr unsigned COPY_TOTAL = COPY_G0 + COPY_G1 + COPY_G2, COPY_CHUNK = 8192u, COPY_NCHUNK1 = COPY_TOTAL / COPY_CHUNK;
static_assert(COPY_TOTAL % COPY_CHUNK == 0, "copy chunks");
__device__ __forceinline__ unsigned xb_ld(unsigned* p) { return __hip_atomic_load(p, __ATOMIC_RELAXED, __HIP_MEMORY_SCOPE_AGENT); }
__device__ __forceinline__ unsigned xb_add(unsigned* p, unsigned v) { return __hip_atomic_fetch_add(p, v, __ATOMIC_RELAXED, __HIP_MEMORY_SCOPE_AGENT); }
__device__ __forceinline__ unsigned xb_xcc_id() { return (unsigned)__builtin_amdgcn_s_getreg((3 << 11) | 20) & 0xFu; }
__device__ __forceinline__ void copy_decode(unsigned e, int& g, unsigned& Lb, unsigned& b, unsigned& rem) {
    if (e < COPY_G0) g = 0; else if (e < COPY_G0 + COPY_G1) { g = 1; e -= COPY_G0; } else { g = 2; e -= COPY_G0 + COPY_G1; }
    Lb = 128u << (2 * g); const unsigned per_b = (Lb - 8u) * 512u; b = e / per_b; rem = e - b * per_b;
}
__device__ __forceinline__ void copy_chunk(const float* s0, const float* s1, const float* s2, float* out, bf16_t* kcb, unsigned c) {
    f32x4 v[16];
#pragma unroll
    for (int k = 0; k < 16; ++k) {
        int g; unsigned Lb, b, rem; copy_decode(c * COPY_CHUNK + k * 512u + threadIdx.x, g, Lb, b, rem);
        const float* src = g == 0 ? s0 : (g == 1 ? s1 : s2);
        v[k] = __builtin_nontemporal_load((const f32x4*)(src + ((size_t)b * Lb + 8) * 2048) + rem);
    }
#pragma unroll
    for (int k = 0; k < 16; ++k) {
        int g; unsigned Lb, b, rem; copy_decode(c * COPY_CHUNK + k * 512u + threadIdx.x, g, Lb, b, rem);
        float* dst = out + (g == 0 ? O_KS0 : (g == 1 ? O_KS1 : O_KS2));
        __builtin_nontemporal_store(v[k], (f32x4*)(dst + (size_t)b * Lb * 2048) + rem);
        u32x2 o; o.x = pk2(v[k][0], v[k][1]); o.y = pk2(v[k][2], v[k][3]);
        if (g != 2 || ((((rem >> 9) + 8u) & 15u) < 8u))
            *((u32x2*)(kcb + (g == 0 ? 0 : (g == 1 ? KC_OFF1 : KC_OFF2)) + ((size_t)b * (Lb + 8) + 8) * 2048) + rem) = o;
    }
}

__device__ __forceinline__ void transpose_item(const float* W, int ldw, int src_col0, const float* gain, bf16_t* WT, int K, int dst_row0, int k0, LAS float* scr, int lane) {
#pragma unroll
    for (int i = 0; i < 8; ++i) { const int kk = 8 * i + (lane >> 3), ch = lane & 7; const float gn = gain ? gain[k0 + kk] : 1.f;
        const f32x4 v = *(const f32x4*)(W + (size_t)(k0 + kk) * ldw + src_col0 + 4 * ch);
        scr[kk * 33 + 4 * ch] = v[0] * gn; scr[kk * 33 + 4 * ch + 1] = v[1] * gn; scr[kk * 33 + 4 * ch + 2] = v[2] * gn; scr[kk * 33 + 4 * ch + 3] = v[3] * gn; }
    asm volatile("s_waitcnt lgkmcnt(0)" ::: "memory");
    const int c = lane & 7;
#pragma unroll
    for (int j = 0; j < 4; ++j) { const int n = (lane >> 3) + 8 * j; const LAS float* s = scr + (8 * c) * 33 + n;
        u32x4 o; o.x = pk2(s[0 * 33], s[1 * 33]); o.y = pk2(s[2 * 33], s[3 * 33]); o.z = pk2(s[4 * 33], s[5 * 33]); o.w = pk2(s[6 * 33], s[7 * 33]);
        *(u32x4*)(WT + (size_t)(dst_row0 + n) * K + k0 + 8 * c) = o; }
    asm volatile("s_waitcnt lgkmcnt(0)" ::: "memory");
}
__device__ __forceinline__ void sincos_d(double a, float& c, float& s) {
    const double k = __builtin_rint(a * 0.63661977236758134308);
    const double y = __builtin_fma(-k, 1.5707963267948966192, a) - k * 6.123233995736766036e-17;
    const double y2 = y * y;
    double sp = -2.5052108385441718775e-8; sp = sp * y2 + 2.7557319223985890653e-6; sp = sp * y2 - 1.9841269841269841270e-4; sp = sp * y2 + 8.3333333333333333333e-3; sp = sp * y2 - 1.6666666666666666667e-1;
    const double sy = y + y * y2 * sp;
    double cp = 2.0876756987868098979e-9; cp = cp * y2 - 2.7557319223985890653e-7; cp = cp * y2 + 2.4801587301587301587e-5; cp = cp * y2 - 1.3888888888888888889e-3; cp = cp * y2 + 4.1666666666666666667e-2; cp = cp * y2 - 0.5;
    const double cy = 1.0 + y2 * cp;
    const int q = ((int)k) & 3;
    const double cc = (q == 0) ? cy : (q == 1) ? -sy : (q == 2) ? -cy : sy;
    const double ss = (q == 0) ? sy : (q == 1) ? cy : (q == 2) ? -sy : -cy;
    c = (float)cc; s = (float)ss;
}
__device__ __forceinline__ void copy_f4(const float* src, float* dst, size_t n4, size_t gt, size_t nthr) {
    const f32x4* s = (const f32x4*)src; f32x4* d = (f32x4*)dst;
    for (size_t i = gt; i < n4; i += nthr) __builtin_nontemporal_store(__builtin_nontemporal_load(s + i), d + i);
}
constexpr int I_WIN = 16 * 64, I_WOUT = 16 * 32, I_WGU = 16 * 176, I_WDN = 44 * 32, I_WQKV = 16 * 288, I_WQ2 = 16 * 96, I_WO = 16 * 32;
constexpr int NITEMS = 2 * I_WIN + 2 * I_WOUT + 4 * I_WGU + 4 * I_WDN + I_WQKV + I_WQ2 + 2 * I_WO;
__device__ __forceinline__ void weight_item(const Params& P, int it, LAS float* scr, int lane) {
    unsigned char* ws = P.ws;
        int r = it;
        if (r < 2 * I_WIN) { const int l = r / I_WIN; r -= l * I_WIN; const int kb = r / 64, nb = r % 64, pn = nb >> 3, bj = (nb >> 2) & 1, e = nb & 3;
            transpose_item(P.in[7] + (size_t)l * D * 2 * D, 2 * D, bj * D + 128 * pn + 32 * e, P.in[6] + l * D, (bf16_t*)(ws + WS_WIN) + (size_t)l * 2 * D * D, D, 32 * nb, 64 * kb, scr, lane); return; }
        r -= 2 * I_WIN;
        if (r < 2 * I_WOUT) { const int l = r / I_WOUT; r -= l * I_WOUT; const int kb = r / 32, nb = r % 32;
            transpose_item(P.in[13] + (size_t)l * D * D, D, 32 * nb, nullptr, (bf16_t*)(ws + WS_WOUT) + (size_t)l * D * D, D, 32 * nb, 64 * kb, scr, lane); return; }
        r -= 2 * I_WOUT;
        if (r < 4 * I_WGU) { const int l = r / I_WGU; r -= l * I_WGU; const int kb = r / 176, nb = r % 176, pn = nb >> 3, bj = (nb >> 2) & 1, e = nb & 3;
            transpose_item(P.in[23] + (size_t)l * D * 2 * FF, 2 * FF, bj * FF + 128 * pn + 32 * e, P.in[22] + l * D, (bf16_t*)(ws + WS_WGU) + (size_t)l * 2 * FF * D, D, 32 * nb, 64 * kb, scr, lane); return; }
        r -= 4 * I_WGU;
        if (r < 4 * I_WDN) { const int l = r / I_WDN; r -= l * I_WDN; const int kb = r / 32, nb = r % 32;
            transpose_item(P.in[24] + (size_t)l * FF * D, D, 32 * nb, nullptr, (bf16_t*)(ws + WS_WDN) + (size_t)l * D * FF, FF, 32 * nb, 64 * kb, scr, lane); return; }
        r -= 4 * I_WDN;
        if (r < I_WQKV) { const int kb = r / 288, nb = r % 288, pn = nb >> 3, bj = (nb >> 2) & 1, wc = nb & 3;
            if (pn < 24) { const int g = pn >> 3, kvsel = (pn >> 2) & 1, hq = pn & 3;
                transpose_item(P.in[16], 2 * GH, g * 2048 + kvsel * 1024 + (4 * hq + wc) * 64 + 32 * bj, P.in[15], (bf16_t*)(ws + WS_WQKV), D, 32 * nb, 64 * kb, scr, lane); }
            else { const int pq = pn - 24, g = pq >> 2, hq = pq & 3;
                transpose_item(P.in[19], GH, g * 1024 + (4 * hq + wc) * 64 + 32 * bj, P.in[18], (bf16_t*)(ws + WS_WQKV), D, 32 * nb, 64 * kb, scr, lane); }
            return; }
        r -= I_WQKV;
        if (r < I_WQ2) { const int kb = r / 96, nb = r % 96, pn = nb >> 3, bj = (nb >> 2) & 1, wc = nb & 3, g = pn >> 2, hq = pn & 3;
            transpose_item(P.in[19] + (size_t)D * GH, GH, g * 1024 + (4 * hq + wc) * 64 + 32 * bj, P.in[18] + D, (bf16_t*)(ws + WS_WQ2), D, 32 * nb, 64 * kb, scr, lane); return; }
        r -= I_WQ2;
        { const int l = r / I_WO; r -= l * I_WO; const int kb = r / 32, nb = r % 32;
            transpose_item(P.in[21] + (size_t)l * D * D, D, 32 * nb, nullptr, (bf16_t*)(ws + WS_WO) + (size_t)l * D * D, D, 32 * nb, 64 * kb, scr, lane); }
}
__device__ __forceinline__ int need_to_orig(int n) {
    if (n < 1024) return n;
    if (n < 1536) return n - 1024 + 2048;
    if (n < 4352) return n - 1536 + 3072;
    if (n < 5760) return n - 4352 + 14336;
    if (n < 6784) return n - 5760 + 1024;
    if (n < 7296) return n - 6784 + 2560;
    if (n < 10112) return n - 7296 + 5888;
    if (n < 11520) return n - 10112 + 15744;
    if (n < 16128) return n - 11520 + 19968;
    if (n < 16640) return n - 16128 + 26112;
    if (n < 19456) return n - 16640 + 8704;
    if (n < 20864) return n - 19456 + 17152;
    if (n < 22400) return n - 20864 + 24576;
    if (n < 22912) return n - 22400 + 26624;
    if (n < 25728) return n - 22912 + 11520;
    return n - 25728 + 18560;
}
constexpr unsigned QW1 = 2016u - 128u, QCP = QW1 + COPY_NCHUNK1, QTOT = QCP + (3392u - 2016u);
__device__ __noinline__ void work_item(const Params* Pp, unsigned q, LAS unsigned char* lds) {
    const Params& P = *Pp;
    if (q >= QW1 && q < QCP) { copy_chunk(P.in[3], P.in[4], P.in[5], P.out, (bf16_t*)(P.ws + WS_KC), q - QW1); return; }
    const int bi = q < QW1 ? 128 + (int)q : 2016 + (int)(q - QCP);
    const int lane = threadIdx.x & 63, wave = threadIdx.x >> 6;
    weight_item(P, need_to_orig(8 * bi + wave), (LAS float*)(lds + wave * 16384), lane);
}
__host__ __device__ constexpr unsigned work_need(int p) {
    return p <= 2 ? 0u : p == 3 ? 64u : p == 4 ? 416u : p == 5 ? 592u : p <= 7 ? 720u : p == 8 ? 784u : p == 9 ? 1136u : p == 10 ? 1312u : p == 11 ? 1888u
         : p <= 13 ? QCP : p == 14 ? QCP + 64u : p == 15 ? QCP + 416u : p == 16 ? QCP + 592u : p <= 19 ? QCP + 784u : p == 20 ? QCP + 848u : p == 21 ? QCP + 1200u : QTOT;
}
__device__ __forceinline__ void phase_prologue(const Params& P, LAS unsigned char* lds) {
    const int tid = threadIdx.x, lane = tid & 63, wave = tid >> 6;
    const int gw = blockIdx.x * 8 + wave, NGW = gridDim.x * 8;
    unsigned char* ws = P.ws;
    LAS float* scr = (LAS float*)(lds + wave * 16384);
    for (int it = gw; it < I_WIN; it += NGW) weight_item(P, it, scr, lane);
#if !ONE_LAUNCH
    { const Params* kp = (const Params*)__builtin_amdgcn_kernarg_segment_ptr(); for (unsigned q = blockIdx.x; q < QTOT; q += gridDim.x) work_item(kp, q, lds); }
#endif
    {
        bf16_t* XB = (bf16_t*)(ws + WS_XB); float* ss0 = (float*)(ws + WS_CTL + SS_OFF);
        for (int m0 = gw; m0 < M; m0 += 4 * NGW) {
            f32x4 v[4][4];
#pragma unroll
            for (int k = 0; k < 4; ++k) { int m = m0 + k * NGW; if (m >= M) m = m0;
                const float* xr = m < MP ? P.in[0] + (size_t)m * D : P.in[1] + (size_t)(m - MP) * D;
#pragma unroll
                for (int j = 0; j < 4; ++j) v[k][j] = *((const f32x4*)xr + lane + 64 * j); }
#pragma unroll
            for (int k = 0; k < 4; ++k) { const int m = m0 + k * NGW; if (m >= M) continue;
                float sm = 0.f;
#pragma unroll
                for (int j = 0; j < 4; ++j) { const f32x4 w = v[k][j]; sm += w[0] * w[0] + w[1] * w[1] + w[2] * w[2] + w[3] * w[3];
                    u32x2 o; o.x = pk2(w[0], w[1]); o.y = pk2(w[2], w[3]); *((u32x2*)(XB + (size_t)m * D) + lane + 64 * j) = o; }
                sm = wave_sum_dpp(sm);
                if (lane == 0) ss0[m] = sm; }
        }
    }
    const size_t gt = (size_t)blockIdx.x * 512 + tid, nthr = (size_t)gridDim.x * 512;
    {
        float* CS = (float*)(ws + WS_CS);
        for (size_t e = gt; e < (size_t)(SEQ + 8) * 32; e += nthr) {
            const int pi = (int)(e >> 5), i = (int)(e & 31); const int pos = pi < SEQ ? pi : 8192 + (pi - SEQ);
            const float invf = (float)exp2(-(double)i * (13.287712379549449 / 32.0));
            float c, s; sincos_d((double)pos * (double)invf, c, s);
            CS[2 * e] = c; CS[2 * e + 1] = s;
        }
    }
    for (size_t e = gt; e < (size_t)2 * 32 * 22 * 256; e += nthr) {
        const size_t lb = e / (22 * 256), rem = e % (22 * 256);
        ((f32x4*)(P.out + O_CS + lb * 30 * D))[rem] = ((const f32x4*)(P.in[2] + lb * 30 * D + 8 * D))[rem];
    }
    for (size_t e = gt; e < (size_t)3 * 32 * 8 * 512; e += nthr) {
        const int g = (int)(e / (32 * 8 * 512)); const size_t r2 = e % (32 * 8 * 512), b = r2 / (8 * 512), rem = r2 % (8 * 512);
        const int Lb = 128 << (2 * g);
        const f32x4 v = *((const f32x4*)(P.in[3 + g] + b * Lb * 2048) + rem);
        u32x2 o; o.x = pk2(v[0], v[1]); o.y = pk2(v[2], v[3]);
        *((u32x2*)((bf16_t*)(ws + WS_KC) + (g == 0 ? 0 : (g == 1 ? KC_OFF1 : KC_OFF2)) + b * (Lb + 8) * 2048) + rem) = o;
    }
}

__device__ __forceinline__ void phase_conv(const Params& P, LAS unsigned char* lds, int layer) {
    const int tid = threadIdx.x, lane = tid & 63, wave = tid >> 6, c0 = 2 * tid;
    const bf16_t* GLU = (const bf16_t*)(P.ws + WS_GLU); bf16_t* HB = (bf16_t*)(P.ws + WS_HB);
    const float* wdw = P.in[9] + (size_t)layer * 31 * D;
    f32x2 wv[31];
#pragma unroll
    for (int w = 0; w < 31; ++w) wv[w] = *(const f32x2*)(wdw + w * D + c0);
    const f32x2 bdw = *(const f32x2*)(P.in[10] + layer * D + c0), lng = *(const f32x2*)(P.in[11] + layer * D + c0), lnb = *(const f32x2*)(P.in[12] + layer * D + c0);
    LAS float* red = (LAS float*)(lds + 62 * 2048);
    for (int u = blockIdx.x; u < 544; u += gridDim.x) {
        const bool sample = u >= 512;
        const int b = sample ? u - 512 : u >> 7, t0 = sample ? 0 : (u & 127) * 32, nstep = sample ? 1 : 4;
        const size_t rowbase = sample ? (size_t)MP + b * 8 : (size_t)b * SEQ;
        __syncthreads();
        if (!sample) {
#pragma unroll
            for (int k = 0; k < 16; ++k) { const int q = tid + 512 * k, rr = q >> 7, part = q & 127, grow = t0 - 30 + rr;
                if (q < 62 * 128) { u32x4 v = {0u, 0u, 0u, 0u}; if (grow >= 0) v = *(const u32x4*)(GLU + (rowbase + grow) * D + part * 8); *(LAS u32x4*)(lds + rr * 2048 + part * 16) = v; } }
        } else {
            const float* prev = P.in[2] + (size_t)(layer * 32 + b) * 30 * D;
#pragma unroll
            for (int k = 0; k < 10; ++k) { const int q = tid + 512 * k, rr = q >> 7, part = q & 127;
                if (q < 38 * 128) { u32x4 v;
                    if (rr < 30) { const f32x4 f0 = *(const f32x4*)(prev + (size_t)rr * D + part * 8), f1 = *(const f32x4*)(prev + (size_t)rr * D + part * 8 + 4); v = pack8(f0, f1); }
                    else v = *(const u32x4*)(GLU + (rowbase + rr - 30) * D + part * 8);
                    *(LAS u32x4*)(lds + rr * 2048 + part * 16) = v; } }
        }
        __syncthreads();
        for (int st = 0; st < nstep; ++st) {
            f32x2 av[8];
#pragma unroll
            for (int tt = 0; tt < 8; ++tt) av[tt] = bdw;
            const LAS unsigned char* lp = lds + (8 * st) * 2048 + tid * 4;
#pragma unroll
            for (int i = 0; i < 38; ++i) {
                const unsigned v = *(const LAS unsigned*)(lp + i * 2048);
                const f32x2 gg = {bflo(v), bfhi(v)};
#pragma unroll
                for (int tt = 0; tt < 8; ++tt) { const int w = i - tt; if (w >= 0 && w <= 30) av[tt] = __builtin_elementwise_fma(wv[w], gg, av[tt]); }
            }
            float a0[8], a1[8];
#pragma unroll
            for (int tt = 0; tt < 8; ++tt) { a0[tt] = av[tt][0]; a1[tt] = av[tt][1]; }
            float s1[8], s2[8];
#pragma unroll
            for (int tt = 0; tt < 8; ++tt) { s1[tt] = wave_sum_dpp(a0[tt] + a1[tt]); s2[tt] = wave_sum_dpp(a0[tt] * a0[tt] + a1[tt] * a1[tt]); }
            if (lane == 0) {
#pragma unroll
                for (int tt = 0; tt < 8; ++tt) { red[wave * 16 + 2 * tt] = s1[tt]; red[wave * 16 + 2 * tt + 1] = s2[tt]; }
            }
            __syncthreads();
            if (tid < 16) { float sm = 0.f;
#pragma unroll
                for (int w = 0; w < 8; ++w) sm += red[w * 16 + tid];
                red[128 + tid] = sm; }
            __syncthreads();
#pragma unroll
            for (int tt = 0; tt < 8; ++tt) {
                const float mean = red[128 + 2 * tt] * (1.f / D), var = red[128 + 2 * tt + 1] * (1.f / D) - mean * mean, rstd = rsqrtf(var + EPS);
                const float y0 = (a0[tt] - mean) * rstd * lng[0] + lnb[0], y1 = (a1[tt] - mean) * rstd * lng[1] + lnb[1];
                *(unsigned*)(HB + (rowbase + t0 + 8 * st + tt) * D + c0) = pk2(y0 * sigmoidf_(y0), y1 * sigmoidf_(y1));
            }
        }
    }
    __syncthreads();
}

constexpr int KSTR = 144, VSTR = 192, LDS_V = 384 * KSTR;
static_assert(LDS_V + 384 * VSTR <= 131072, "attention LDS");
struct AttnRegs { u32x4 kv[6], vv[6]; bf16x8 qf[4]; };
__device__ __forceinline__ void attn_decode(int u, int& g, int& r, int& rho, int& h, int& b, int& l0) {
    g = u >> 10; const int rem = u & 1023;
    r = 1 << (2 * g); const int nblk = 16 >> (2 * g);
    const int blk = rem & (nblk - 1); rho = (rem >> (4 - 2 * g)) & (r - 1); h = (rem >> 4) & 15; b = rem >> 8;
    l0 = blk * 256;
}
__device__ __forceinline__ void attn_prompt_load(int u, AttnRegs& R, const bf16_t* QB, const bf16_t* KB, const bf16_t* VB) {
    const int tid = threadIdx.x, lane = tid & 63, w = __builtin_amdgcn_readfirstlane(tid >> 6), l32 = lane & 31, hh = lane >> 5;
    int g, r, rho, h, b, l0; attn_decode(u, g, r, rho, h, b, l0);
    const size_t colbase = (size_t)g * 1024 + h * 64;
#pragma unroll
    for (int c = 0; c < 6; ++c) {
        const int chunk = tid + 512 * c, key = chunk >> 3, part = chunk & 7, l = l0 - 128 + key;
        R.kv[c] = (u32x4){0u, 0u, 0u, 0u}; R.vv[c] = (u32x4){0u, 0u, 0u, 0u};
        if (l >= 0) { const size_t off = ((size_t)b * SEQ + (size_t)l * r + rho) * GH + colbase + part * 8; R.kv[c] = *(const u32x4*)(KB + off); R.vv[c] = *(const u32x4*)(VB + off); }
    }
    const size_t qrow = (size_t)b * SEQ + (size_t)(l0 + 32 * w + l32) * r + rho;
#pragma unroll
    for (int ks = 0; ks < 4; ++ks) R.qf[ks] = *(const bf16x8*)(QB + qrow * GH + colbase + 16 * ks + 8 * hh);
}
__device__ __forceinline__ void attn_prompt_stage(LAS unsigned char* lds, const AttnRegs& R) {
    const int tid = threadIdx.x;
#pragma unroll
    for (int c = 0; c < 6; ++c) {
        const int chunk = tid + 512 * c, key = chunk >> 3, part = chunk & 7;
        *(LAS u32x4*)(lds + key * KSTR + part * 16) = R.kv[c]; *(LAS u32x4*)(lds + LDS_V + key * VSTR + part * 16) = R.vv[c];
    }
}
__device__ __forceinline__ void attn_prompt_compute(LAS unsigned char* lds, int u, const bf16x8 (&qf)[4], bf16_t* OG, float* LSE) {
    const int tid = threadIdx.x, lane = tid & 63, w = __builtin_amdgcn_readfirstlane(tid >> 6), l32 = lane & 31, hh = lane >> 5;
    int g, r, rho, h, b, l0; attn_decode(u, g, r, rho, h, b, l0);
    const size_t qrow = (size_t)b * SEQ + (size_t)(l0 + 32 * w + l32) * r + rho;
    f32x16 s[5];
    {
        const LAS unsigned char* kbase = lds + (32 * w + l32) * KSTR + hh * 16;
        bf16x8 ka[2][4];
#pragma unroll
        for (int ks = 0; ks < 4; ++ks) ka[0][ks] = *(const LAS bf16x8*)(kbase + ks * 32);
#pragma unroll
        for (int kb = 0; kb < 5; ++kb) {
            if (kb < 4) {
#pragma unroll
                for (int ks = 0; ks < 4; ++ks) ka[(kb + 1) & 1][ks] = *(const LAS bf16x8*)(kbase + (32 * (kb + 1)) * KSTR + ks * 32);
            }
            __builtin_amdgcn_sched_barrier(0);
#pragma unroll
            for (int i = 0; i < 16; ++i) s[kb][i] = 0.f;
#pragma unroll
            for (int ks = 0; ks < 4; ++ks) s[kb] = __builtin_amdgcn_mfma_f32_32x32x16_bf16(ka[kb & 1][ks], qf[ks], s[kb], 0, 0, 0);
            __builtin_amdgcn_sched_barrier(0);
        }
    }
    {
        const int d0 = 4 * hh - l32;
#pragma unroll
        for (int i = 0; i < 16; ++i) { const int xi = 8 * (i >> 2) + (i & 3);
            s[0][i] = (xi + d0 >= 0) ? s[0][i] : -3.0e38f;
            s[4][i] = (xi + d0 <= 0) ? s[4][i] : -3.0e38f; }
        if (l0 == 0 && w < 4) {
            const int k0 = 32 * w + 4 * hh - 128;
#pragma unroll
            for (int kb = 0; kb < 4; ++kb)
#pragma unroll
                for (int i = 0; i < 16; ++i) { const int xi = 8 * (i >> 2) + (i & 3); s[kb][i] = (32 * kb + xi + k0 >= 0) ? s[kb][i] : -3.0e38f; }
        }
    }
    float mx = -3.0e38f;
#pragma unroll
    for (int kb = 0; kb < 5; ++kb)
#pragma unroll
        for (int i = 0; i < 16; i += 2) mx = fmaxf(mx, fmaxf(s[kb][i], s[kb][i + 1]));
    mx = half_swap_max(mx);
    float sum = 0.f;
#pragma unroll
    for (int kb = 0; kb < 5; ++kb)
#pragma unroll
        for (int i = 0; i < 16; ++i) { const float p = __builtin_amdgcn_exp2f(s[kb][i] - mx); s[kb][i] = p; sum += p; }
    sum = half_swap_sum(sum);
    f32x16 o[2];
#pragma unroll
    for (int i = 0; i < 16; ++i) { o[0][i] = 0.f; o[1][i] = 0.f; }
    const int gi = (lane >> 4) & 1, q4 = (lane >> 2) & 3, p4 = lane & 3;
    const LAS unsigned char* vbase = lds + LDS_V + (32 * w + 4 * hh + q4) * VSTR + (16 * gi + 4 * p4) * 2;
#pragma unroll
    for (int c = 0; c < 10; ++c) {
        const int kb = c >> 1, c2 = c & 1;
        u32x4 pw; pw.x = pk2(s[kb][8 * c2 + 0], s[kb][8 * c2 + 1]); pw.y = pk2(s[kb][8 * c2 + 2], s[kb][8 * c2 + 3]); pw.z = pk2(s[kb][8 * c2 + 4], s[kb][8 * c2 + 5]); pw.w = pk2(s[kb][8 * c2 + 6], s[kb][8 * c2 + 7]);
        const bf16x8 pb = __builtin_bit_cast(bf16x8, pw);
#pragma unroll
        for (int db = 0; db < 2; ++db) {
            const s16x4 lo = __builtin_bit_cast(s16x4, __builtin_amdgcn_ds_read_tr16_b64_v4i16((LAS s16x4*)(vbase + (16 * c) * VSTR + db * 64)));
            const s16x4 hi = __builtin_bit_cast(s16x4, __builtin_amdgcn_ds_read_tr16_b64_v4i16((LAS s16x4*)(vbase + (16 * c + 8) * VSTR + db * 64)));
            bf16x8 a; a[0] = lo[0]; a[1] = lo[1]; a[2] = lo[2]; a[3] = lo[3]; a[4] = hi[0]; a[5] = hi[1]; a[6] = hi[2]; a[7] = hi[3];
            o[db] = __builtin_amdgcn_mfma_f32_32x32x16_bf16(a, pb, o[db], 0, 0, 0);
        }
    }
    const float inv = 1.f / sum;
    bf16_t* op = OG + ((size_t)g * M + qrow) * D + h * 64;
#pragma unroll
    for (int db = 0; db < 2; ++db)
#pragma unroll
        for (int i4 = 0; i4 < 4; ++i4) {
            u32x2 ov; ov.x = pk2(o[db][4 * i4] * inv, o[db][4 * i4 + 1] * inv); ov.y = pk2(o[db][4 * i4 + 2] * inv, o[db][4 * i4 + 3] * inv);
            *(u32x2*)(op + 32 * db + 8 * i4 + 4 * hh) = ov;
        }
    if (hh == 0) LSE[((size_t)g * M + qrow) * 16 + h] = (mx + __builtin_amdgcn_logf(sum)) * LN2;
}
__device__ __forceinline__ void attn_sample_task(const Params& P, int task, int lane, LAS float* wl) {
    const bf16_t* QB = (const bf16_t*)(P.ws + WS_QB);
    bf16_t* OG = (bf16_t*)(P.ws + WS_OG); float* LSE = (float*)(P.ws + WS_LSE);
    const int t = task & 7, h = (task >> 3) & 15, g = (task >> 7) % 3, b = task / 384;
    const int Lb = 128 << (2 * g), r = 1 << (2 * g);
    const bf16_t* kc = (const bf16_t*)(P.ws + WS_KC) + (g == 0 ? 0 : (g == 1 ? KC_OFF1 : KC_OFF2)) + (size_t)b * (Lb + 8) * 2048 + h * 64;
    const size_t qrow = (size_t)MP + b * 8 + t, colbase = (size_t)g * 1024 + h * 64;
    LAS float* qs = wl; LAS float* ps = wl + 64;
    const unsigned qraw = (unsigned)QB[qrow * GH + colbase + lane];
    const int top = Lb + t;
    u32x4 k0[8], k1[8];
    { const u32x4* p0 = (const u32x4*)(kc + (size_t)(top - r * lane) * 2048); const u32x4* p1 = (const u32x4*)(kc + (size_t)(top - r * (lane + 64)) * 2048);
#pragma unroll
      for (int c = 0; c < 8; ++c) { k0[c] = p0[c]; k1[c] = p1[c]; } }
    const int dp = lane & 31, kp = lane >> 5;
    const bf16_t* vb = kc + 1024 + 2 * dp;
    unsigned vv[65];
#pragma unroll
    for (int e = 0; e < 65; ++e) { int j = 2 * e + kp; j = j > 128 ? 128 : j; vv[e] = *(const unsigned*)(vb + (size_t)(top - r * j) * 2048); }
    const unsigned kk128 = (unsigned)kc[(size_t)(top - r * 128) * 2048 + lane];
    qs[lane] = bflo(qraw);
    __builtin_amdgcn_wave_barrier();
    float sc0 = 0.f, sc1 = 0.f, sc2 = 0.f;
#pragma unroll
    for (int c = 0; c < 8; ++c) { const f32x4 qa = *(const LAS f32x4*)(qs + 8 * c), qb = *(const LAS f32x4*)(qs + 8 * c + 4);
        sc0 += qa[0] * bflo(k0[c].x) + qa[1] * bfhi(k0[c].x) + qa[2] * bflo(k0[c].y) + qa[3] * bfhi(k0[c].y) + qb[0] * bflo(k0[c].z) + qb[1] * bfhi(k0[c].z) + qb[2] * bflo(k0[c].w) + qb[3] * bfhi(k0[c].w);
        sc1 += qa[0] * bflo(k1[c].x) + qa[1] * bfhi(k1[c].x) + qa[2] * bflo(k1[c].y) + qa[3] * bfhi(k1[c].y) + qb[0] * bflo(k1[c].z) + qb[1] * bfhi(k1[c].z) + qb[2] * bflo(k1[c].w) + qb[3] * bfhi(k1[c].w); }
    sc2 = wave_sum_dpp(qs[lane] * bflo(kk128));
    const float mx = wave_max_dpp(fmaxf(fmaxf(sc0, sc1), sc2));
    const float p0 = __builtin_amdgcn_exp2f(sc0 - mx), p1 = __builtin_amdgcn_exp2f(sc1 - mx), p2 = __builtin_amdgcn_exp2f(sc2 - mx);
    const float sum = wave_sum_dpp(p0 + p1) + p2;
    ps[lane] = p0; ps[64 + lane] = p1; if (lane < 2) ps[128 + lane] = lane == 0 ? p2 : 0.f;
    __builtin_amdgcn_wave_barrier();
    float o0 = 0.f, o1 = 0.f;
#pragma unroll
    for (int e = 0; e < 65; ++e) { const float pj = ps[2 * e + kp]; o0 += pj * bflo(vv[e]); o1 += pj * bfhi(vv[e]); }
    o0 = half_swap_sum(o0); o1 = half_swap_sum(o1);
    const float inv = 1.f / sum;
    if (kp == 0) *(unsigned*)(OG + ((size_t)g * M + qrow) * D + h * 64 + 2 * dp) = pk2(o0 * inv, o1 * inv);
    if (lane == 0) LSE[((size_t)g * M + qrow) * 16 + h] = (mx + __builtin_amdgcn_logf(sum)) * LN2;
    __builtin_amdgcn_wave_barrier();
}
__device__ __forceinline__ void phase_attn(const Params& P, LAS unsigned char* lds) {
    const int tid = threadIdx.x, lane = tid & 63, wave = tid >> 6;
    const int gw = blockIdx.x * 8 + wave, NGW = gridDim.x * 8;
#ifndef SKIP_SAMPLE
    for (int rs_ = 0; rs_ < PROBE_ASM; ++rs_)
    for (int task = gw; task < DECB * 3 * 16 * DECT; task += NGW) attn_sample_task(P, task, lane, (LAS float*)(lds + wave * 1024));
#endif
    const bf16_t* QB = (const bf16_t*)(P.ws + WS_QB); const bf16_t* KB = (const bf16_t*)(P.ws + WS_KB); const bf16_t* VB = (const bf16_t*)(P.ws + WS_VB);
    bf16_t* OG = (bf16_t*)(P.ws + WS_OG); float* LSE = (float*)(P.ws + WS_LSE);
    __syncthreads();
#ifndef SKIP_PROMPT
    for (int rq_ = 0; rq_ < PROBE_APR; ++rq_) {
        AttnRegs R;
        int u = blockIdx.x;
        if (u < 3072) attn_prompt_load(u, R, QB, KB, VB);
        while (u < 3072) {
            const int un = u + gridDim.x;
            attn_prompt_stage(lds, R);
            bf16x8 qf[4];
#pragma unroll
            for (int ks = 0; ks < 4; ++ks) qf[ks] = R.qf[ks];
            __syncthreads();
            if (un < 3072) attn_prompt_load(un, R, QB, KB, VB);
            attn_prompt_compute(lds, u, qf, OG, LSE);
            __syncthreads();
            u = un;
        }
    }
#endif
}
__device__ __forceinline__ void phase_merge(const Params& P) {
    const bf16_t* OG = (const bf16_t*)(P.ws + WS_OG); const float* LSE = (const float*)(P.ws + WS_LSE); bf16_t* O = (bf16_t*)(P.ws + WS_HB);
    const size_t gt = (size_t)blockIdx.x * 512 + threadIdx.x, nthr = (size_t)gridDim.x * 512;
    constexpr size_t NIT = (size_t)M * 128;
    for (size_t it0 = gt; it0 < NIT; it0 += 4 * nthr) {
        float l[4][3]; u32x4 a[4], bq[4], c[4]; size_t off[4];
#pragma unroll
        for (int k = 0; k < 4; ++k) {
            size_t it = it0 + k * nthr; if (it >= NIT) it = it0;
            const size_t row = it >> 7; const int h = (int)(it >> 3) & 15, c8 = (int)it & 7;
            l[k][0] = LSE[row * 16 + h]; l[k][1] = LSE[((size_t)M + row) * 16 + h]; l[k][2] = LSE[((size_t)2 * M + row) * 16 + h];
            off[k] = row * D + h * 64 + c8 * 8;
            a[k] = *(const u32x4*)(OG + off[k]); bq[k] = *(const u32x4*)(OG + (size_t)M * D + off[k]); c[k] = *(const u32x4*)(OG + (size_t)2 * M * D + off[k]);
        }
#pragma unroll
        for (int k = 0; k < 4; ++k) {
            if (it0 + k * nthr >= NIT) continue;
            const float mx = fmaxf(l[k][0], fmaxf(l[k][1], l[k][2]));
            float w0 = __expf(l[k][0] - mx), w1 = __expf(l[k][1] - mx), w2 = __expf(l[k][2] - mx);
            const float inv = 1.f / (w0 + w1 + w2); w0 *= inv; w1 *= inv; w2 *= inv;
            u32x4 o;
            o.x = pk2(w0 * bflo(a[k].x) + w1 * bflo(bq[k].x) + w2 * bflo(c[k].x), w0 * bfhi(a[k].x) + w1 * bfhi(bq[k].x) + w2 * bfhi(c[k].x));
            o.y = pk2(w0 * bflo(a[k].y) + w1 * bflo(bq[k].y) + w2 * bflo(c[k].y), w0 * bfhi(a[k].y) + w1 * bfhi(bq[k].y) + w2 * bfhi(c[k].y));
            o.z = pk2(w0 * bflo(a[k].z) + w1 * bflo(bq[k].z) + w2 * bflo(c[k].z), w0 * bfhi(a[k].z) + w1 * bfhi(bq[k].z) + w2 * bfhi(c[k].z));
            o.w = pk2(w0 * bflo(a[k].w) + w1 * bflo(bq[k].w) + w2 * bflo(c[k].w), w0 * bfhi(a[k].w) + w1 * bfhi(bq[k].w) + w2 * bfhi(c[k].w));
            *(u32x4*)(O + off[k]) = o;
        }
    }
}


#define XB_XCNT(j)  (256  + 64 * (j))
#define XB_XSUB(j)  (1280 + 64 * (j))
#define XB_XGEN(j)  (2304 + 64 * (j))
#define XB_TOP      3328
#define XB_TOPGEN   3392
#define XB_COPY     3456
struct GridBar { unsigned* bar; unsigned x; volatile LAS unsigned* st; LAS unsigned char* lds; const Params* kp; };
__device__ __forceinline__ GridBar grid_bar_post(unsigned* bar, volatile LAS unsigned* st) {
    GridBar b; b.bar = bar; b.x = xb_xcc_id(); b.st = st; b.lds = nullptr; b.kp = nullptr;
    if (threadIdx.x == 0) (void)xb_add(&bar[XB_XCNT(b.x)], 1u);
    return b;
}
__device__ __forceinline__ void grid_barrier(const GridBar& b, const Params& P, bool& copy_left) {
    asm volatile("s_waitcnt vmcnt(0)" ::: "memory");
    __syncthreads();
    unsigned gen = 0u, tg = 0u; bool leader = false;
    unsigned* bar = b.bar;
    if (threadIdx.x == 0) {
        __builtin_amdgcn_s_waitcnt(0);
        unsigned nloc = b.st[0], nx = b.st[1];
        if (nloc == 0u) {
            const unsigned G = gridDim.x; unsigned sp = 0u;
            for (;;) { unsigned sum = 0u, cnt = 0u, mine = 0u;
#pragma unroll
                for (unsigned j = 0; j < 16; ++j) { const unsigned c = xb_ld(&bar[XB_XCNT(j)]); sum += c; cnt += (c > 0u) ? 1u : 0u; mine = (j == b.x) ? c : mine; }
                nloc = mine > 0u ? mine : 1u; nx = cnt > 0u ? cnt : 1u;
                if (sum == G || ++sp > (1u << 22)) break;
                __builtin_amdgcn_s_sleep(1); }
            b.st[0] = nloc; b.st[1] = nx;
        }
        const unsigned old = xb_add(&bar[XB_XSUB(b.x)], 1u);
        gen = old / nloc;
        if (old + 1u == (gen + 1u) * nloc) {
            leader = true;
            __builtin_amdgcn_fence(__ATOMIC_RELEASE, "agent");
            asm volatile("s_waitcnt vmcnt(0)" ::: "memory");
            const unsigned og = xb_add(&bar[XB_TOP], 1u);
            tg = og / nx;
            if (og + 1u == (tg + 1u) * nx) xb_add(&bar[XB_TOPGEN], 1u);
        }
    }
    unsigned spins = 0u;
    for (;;) {
        if (threadIdx.x == 0) {
            const bool done = leader ? (xb_ld(&bar[XB_TOPGEN]) != tg) : (xb_ld(&bar[XB_XGEN(b.x)]) != gen);
            b.st[2] = (done || ++spins > (1u << 24)) ? 1u : 0u;
            if (!done && copy_left) b.st[3] = xb_add(&bar[XB_COPY], 1u);
        }
        __syncthreads();
        const unsigned d = b.st[2], c = b.st[3];
        __syncthreads();
        if (d) break;
        if (copy_left) { if (c < QTOT) work_item(b.kp, c, b.lds); else copy_left = false; }
        else __builtin_amdgcn_s_sleep(2);
    }
    if (threadIdx.x == 0) {
        __builtin_amdgcn_fence(__ATOMIC_ACQUIRE, "agent");
        if (leader) xb_add(&bar[XB_XGEN(b.x)], 1u);
        asm volatile("s_waitcnt vmcnt(0)" ::: "memory");
    }
    __syncthreads();
}
__device__ __forceinline__ void work_drain(const GridBar& b, const Params& P, bool& copy_left, unsigned wm) {
    while (copy_left) {
        if (threadIdx.x == 0) { const unsigned cur = xb_ld(&b.bar[XB_COPY]); b.st[3] = cur >= wm ? 0xffffffffu : xb_add(&b.bar[XB_COPY], 1u); }
        __syncthreads();
        const unsigned c = b.st[3];
        __syncthreads();
        if (c == 0xffffffffu) break;
        if (c < QTOT) work_item(b.kp, c, b.lds); else copy_left = false;
    }
}

template <int K>
__device__ __forceinline__ void skinny_res(LAS unsigned char* lds, const bf16_t* A, const bf16_t* Bt, const float* xold, float* xnew, bf16_t* xb, const float* bias, float* ss_out) {
    const int tid = threadIdx.x, lane = tid & 63, w = tid >> 6, l32 = lane & 31, hh = lane >> 5;
    const int c = blockIdx.x; if (c >= 256) return;
    const int r0 = MP + 32 * (c >> 5), c0 = 32 * (c & 31);
    constexpr int KW = K / 8, NS = KW / 16;
    const bf16_t* ap = A + (size_t)(r0 + l32) * K + w * KW + 8 * hh;
    const bf16_t* bp = Bt + (size_t)(c0 + l32) * K + w * KW + 8 * hh;
    float xo2[2], bs = bias ? bias[c0 + l32] : 0.f;
#pragma unroll
    for (int ii = 0; ii < 2; ++ii) { const int i = 2 * w + ii; xo2[ii] = xold[(size_t)(r0 - MP + 8 * (i >> 2) + 4 * hh + (i & 3)) * D + c0 + l32]; }
    f32x16 acc;
#pragma unroll
    for (int i = 0; i < 16; ++i) acc[i] = 0.f;
    constexpr int BATCHN = NS > 11 ? 11 : NS;
#pragma unroll
    for (int s0 = 0; s0 < NS; s0 += BATCHN) {
        bf16x8 av[BATCHN], bv[BATCHN];
#pragma unroll
        for (int s = 0; s < BATCHN; ++s) { av[s] = *(const bf16x8*)(ap + 16 * (s0 + s)); bv[s] = *(const bf16x8*)(bp + 16 * (s0 + s)); }
#pragma unroll
        for (int s = 0; s < BATCHN; ++s) acc = __builtin_amdgcn_mfma_f32_32x32x16_bf16(av[s], bv[s], acc, 0, 0, 0);
    }
    LAS float* red = (LAS float*)lds;
#pragma unroll
    for (int i = 0; i < 16; ++i) red[(w * 16 + i) * 64 + lane] = acc[i];
    __syncthreads();
#pragma unroll
    for (int ii = 0; ii < 2; ++ii) {
        const int i = 2 * w + ii;
        float v = 0.f;
#pragma unroll
        for (int ww = 0; ww < 8; ++ww) v += red[(ww * 16 + i) * 64 + lane];
        const int row = r0 + 8 * (i >> 2) + 4 * hh + (i & 3), col = c0 + l32;
        const float x = xo2[ii] + v + bs;
        xnew[(size_t)row * D + col] = x;
        xb[(size_t)row * D + col] = (bf16_t)(pk2(x, 0.f) & 0xffffu);
        float sq = x * x;
#pragma unroll
        for (int o = 1; o < 32; o <<= 1) sq += __shfl_xor(sq, o);
        if (ss_out && l32 == 0) atomicAdd(ss_out + row, sq);
    }
    __syncthreads();
}

__global__ void __launch_bounds__(512, 2) mega_fwd(Params P) {
    extern __shared__ __attribute__((aligned(16))) unsigned char lds_raw[];
    LAS unsigned char* lds = (LAS unsigned char*)lds_raw;
    unsigned char* ws = P.ws;
    const int lo = P.ph_lo, hi = P.ph_hi;
    float* SS = (float*)(ws + WS_CTL + SS_OFF);
    bf16_t* XB = (bf16_t*)(ws + WS_XB); bf16_t* GLU = (bf16_t*)(ws + WS_GLU); bf16_t* HB = (bf16_t*)(ws + WS_HB); bf16_t* ACT = (bf16_t*)(ws + WS_ACT);
    bf16_t* QB = (bf16_t*)(ws + WS_QB); bf16_t* KB = (bf16_t*)(ws + WS_KB); bf16_t* VB = (bf16_t*)(ws + WS_VB);
#define IN(k) (lo <= (k) && (k) < hi)
#if ONE_LAUNCH
    volatile LAS unsigned* st = (volatile LAS unsigned*)(lds + 131072);
    if (threadIdx.x < 4) st[threadIdx.x] = 0u;
    __syncthreads();
    GridBar gb = grid_bar_post((unsigned*)(ws + WS_CTL), st); gb.lds = lds; gb.kp = (const Params*)__builtin_amdgcn_kernarg_segment_ptr();
    bool copy_left = true;
#define SEAM(k) do { if ((k) + 1 < hi) { if ((k) == 0) cg::this_grid().sync(); else { if (work_need((k) + 1) > work_need((k))) work_drain(gb, P, copy_left, work_need((k) + 1)); grid_barrier(gb, P, copy_left); } } } while (0)
#else
#define SEAM(k) do { } while (0)
#endif
#ifdef SKIP_GEMM
#define GEMM(EpiT, E, Aptr, Bptr, N_, K_, GP_) do { } while (0)
#else
#define GEMM(EpiT, E, Aptr, Bptr, N_, K_, GP_) do { pg8::Gemm g_{(Aptr), (Bptr), M, (N_), (K_)}; pg8::StaticOrder S_; S_.init(M, (N_), (ONE_LAUNCH && (int)gridDim.x == 256) ? (GP_) : (int)gridDim.x, (int)blockIdx.x); pg8::gemm_phase<EpiT>(lds, g_, S_, (E)); } while (0)
#endif
#define RESGEMM(E, Aptr, Bptr, K_) do { skinny_res<(K_)>(lds, (Aptr), (Bptr), (E).xold_s, (E).xnew, (E).xb, (E).bias, (E).ss_out); \
        pg8::Gemm g_{(Aptr), (Bptr), MP, D, (K_)}; pg8::StaticOrder S_; S_.init(MP, D, (int)gridDim.x, (int)blockIdx.x); pg8::gemm_phase<EpiRes>(lds, g_, S_, (E)); } while (0)
    #ifndef SKIP_PRO
    if (IN(0)) { for (int rp_ = 0; rp_ < PROBE_PR; ++rp_) phase_prologue(P, lds); SEAM(0); }
#endif
#define CONV_LAYER(l, p0) \
    if (IN((p0))) { EpiGLU E{GLU, SS + (size_t)(2 * (l)) * M, P.in[8] + (l) * 2 * D, P.out + O_CP + (size_t)(l) * 4 * 30 * D, P.out + O_CS + (size_t)(l) * 32 * 30 * D}; \
        for (int rw_ = 0; rw_ < PROBE_WIN; ++rw_) { GEMM(EpiGLU, E, XB, (const bf16_t*)(ws + WS_WIN) + (size_t)(l) * 2 * D * D, 2 * D, D, 176); } SEAM((p0)); } \
    if (IN((p0) + 1)) { for (int rp_ = 0; rp_ < PROBE_CV; ++rp_) phase_conv(P, lds, (l)); SEAM((p0) + 1); } \
    if (IN((p0) + 2)) { EpiRes E{(l) == 0 ? P.in[0] : P.out, (l) == 0 ? P.in[1] : P.out + (size_t)MP * D, P.out, XB, P.in[14] + (l) * D, SS + (size_t)(2 * (l) + 1) * M}; \
        RESGEMM(E, HB, (const bf16_t*)(ws + WS_WOUT) + (size_t)(l) * D * D, D); SEAM((p0) + 2); } \
    if (IN((p0) + 3)) { EpiSwiGLU E{ACT, SS + (size_t)(2 * (l) + 1) * M}; \
        for (int rp_ = 0; rp_ < ((l) == 0 ? PROBE_GU : 1); ++rp_) { GEMM(EpiSwiGLU, E, XB, (const bf16_t*)(ws + WS_WGU) + (size_t)(l) * 2 * FF * D, 2 * FF, D, 240); } SEAM((p0) + 3); } \
    if (IN((p0) + 4)) { EpiRes E{P.out, P.out + (size_t)MP * D, P.out, XB, nullptr, SS + (size_t)(2 * (l) + 2) * M}; \
        if (PROBE_DN && (l) == 0) { EpiRes E2 = E; E2.xnew = (float*)(ws + 1100 * MiB) - (size_t)0; E2.xb = (bf16_t*)(ws + 1200 * MiB); E2.ss_out = (float*)(ws + 1300 * MiB); RESGEMM(E2, ACT, (const bf16_t*)(ws + WS_WDN) + (size_t)(l) * D * FF, FF); } \
        RESGEMM(E, ACT, (const bf16_t*)(ws + WS_WDN) + (size_t)(l) * D * FF, FF); SEAM((p0) + 4); }
    CONV_LAYER(0, 1)
    CONV_LAYER(1, 6)
#define ATTN_LAYER(j, l, p0, WQPTR, NQ) \
    if (IN((p0))) { EpiQKV<j> E{ws, P.in[17], P.in[20] + (j) * 3 * 64, P.out}; \
        for (int rq_ = 0; rq_ < ((j) == 0 ? PROBE_QKV : 1); ++rq_) { GEMM(EpiQKV<j>, E, XB, (const bf16_t*)(ws + (WQPTR)), (NQ), D, (j) == 0 ? 240 : 200); } SEAM((p0)); } \
    if (IN((p0) + 1)) { for (int rp_ = 0; rp_ < PROBE_AT; ++rp_) phase_attn(P, lds); SEAM((p0) + 1); } \
    if (IN((p0) + 2)) { for (int rm_ = 0; rm_ < PROBE_MG; ++rm_) phase_merge(P); SEAM((p0) + 2); } \
    if (IN((p0) + 3)) { EpiRes E{P.out, P.out + (size_t)MP * D, P.out, XB, nullptr, SS + (size_t)(2 * (l) + 1) * M}; \
        RESGEMM(E, HB, (const bf16_t*)(ws + WS_WO) + (size_t)(j) * D * D, D); SEAM((p0) + 3); } \
    if (IN((p0) + 4)) { EpiSwiGLU E{ACT, SS + (size_t)(2 * (l) + 1) * M}; \
        GEMM(EpiSwiGLU, E, XB, (const bf16_t*)(ws + WS_WGU) + (size_t)(l) * 2 * FF * D, 2 * FF, D, 240); SEAM((p0) + 4); } \
    if (IN((p0) + 5)) { EpiRes E{P.out, P.out + (size_t)MP * D, P.out, XB, nullptr, (l) == 3 ? nullptr : SS + (size_t)(2 * (l) + 2) * M}; \
        RESGEMM(E, ACT, (const bf16_t*)(ws + WS_WDN) + (size_t)(l) * D * FF, FF); SEAM((p0) + 5); }
    ATTN_LAYER(0, 2, 11, WS_WQKV, 9216)
    ATTN_LAYER(1, 3, 17, WS_WQ2, GH)
#undef CONV_LAYER
#undef ATTN_LAYER
#if ONE_LAUNCH
    work_drain(gb, P, copy_left, QTOT);
#endif
#undef IN
#undef SEAM
#undef GEMM
#undef RESGEMM
}

extern "C" void kernel_launch(void* const* d_in, const int* in_sizes, int n_in, void* d_out, int out_size, void* d_ws, size_t ws_size, hipStream_t stream) {
    static int grid = 0;
    if (grid == 0) {
        if (n_in != 25 || (size_t)out_size != O_END || ws_size < WS_END) { fprintf(stderr, "kernel_launch: unexpected shapes (n_in %d, out %d, ws %zu)\n", n_in, out_size, ws_size); grid = -1; return; }
        int dev = 0, cus = 0, per_cu = 0;
        hipGetDevice(&dev); hipDeviceGetAttribute(&cus, hipDeviceAttributeMultiprocessorCount, dev);
        hipFuncSetAttribute((const void*)mega_fwd, hipFuncAttributeMaxDynamicSharedMemorySize, LDS_BYTES);
        hipOccupancyMaxActiveBlocksPerMultiprocessor(&per_cu, (const void*)mega_fwd, 512, LDS_BYTES);
        if (per_cu < 1) { fprintf(stderr, "kernel_launch: occupancy query says %d blocks/CU\n", per_cu); per_cu = 1; }
        (void)hipGetLastError();
        grid = cus;
    }
    if (grid < 0) return;
    hipMemsetAsync((char*)d_ws + WS_CTL, 0, CTL_BYTES, stream);
    Params p{};
    for (int i = 0; i < 25; ++i) p.in[i] = (const float*)d_in[i];
    p.out = (float*)d_out; p.ws = (unsigned char*)d_ws;
#if ONE_LAUNCH
    p.ph_lo = 0; p.ph_hi = NPH;
    void* args[] = {&p};
    hipError_t e = hipLaunchCooperativeKernel((const void*)mega_fwd, dim3(grid), dim3(512), args, LDS_BYTES, stream);
    if (e != hipSuccess) fprintf(stderr, "cooperative launch failed: %s (grid %d)\n", hipGetErrorString(e), grid);
#else
    for (int k = 0; k < NPH; ++k) { p.ph_lo = k; p.ph_hi = k + 1; hipLaunchKernelGGL(mega_fwd, dim3(grid), dim3(512), LDS_BYTES, stream, p); }
#endif
}
```

```cpp
#include <hip/hip_runtime.h>
#include <hip/hip_cooperative_groups.h>
#include <cstdio>
#include <cstdint>
namespace cg = cooperative_groups;

#define PROBE_GU 1
#define PROBE_ASM 1
#define PROBE_QKV 1
#define PROBE_DN 0
#define PROBE_WIN 1
#define PROBE_MG 1
#define PROBE_APR 1
#define PROBE_AT 1
#define PROBE_CV 1
#define PROBE_PR 1
#ifndef ONE_LAUNCH
#define ONE_LAUNCH 1
#endif

#define LAS __attribute__((address_space(3)))
typedef unsigned short bf16_t;
typedef short bf16x8 __attribute__((ext_vector_type(8)));
typedef short s16x4 __attribute__((ext_vector_type(4)));
typedef float f32x2 __attribute__((ext_vector_type(2)));
typedef float f32x4 __attribute__((ext_vector_type(4)));
typedef float f32x16 __attribute__((ext_vector_type(16)));
typedef unsigned u32x2 __attribute__((ext_vector_type(2)));
typedef unsigned u32x4 __attribute__((ext_vector_type(4)));
typedef __bf16 bf16x2_t __attribute__((ext_vector_type(2)));

constexpr int D = 1024, SEQ = 4096, NBATCH = 4, MP = NBATCH * SEQ, DECB = 32, DECT = 8, MS = DECB * DECT, M = MP + MS;
constexpr int FF = 2816, GH = 3072, NPH = 23;
constexpr float EPS = 1e-6f;
constexpr float QSCALE = 0.125f * 1.4426950408889634f;
constexpr float LN2 = 0.6931471805599453f;

constexpr size_t O_Y = 0;
constexpr size_t O_CP = (size_t)M * D;
constexpr size_t O_CS = O_CP + (size_t)2 * 4 * 30 * D;
constexpr size_t O_KP0 = O_CS + (size_t)2 * 32 * 30 * D;
constexpr size_t O_KP1 = O_KP0 + (size_t)4 * 128 * 2048;
constexpr size_t O_KP2 = O_KP1 + (size_t)4 * 512 * 2048;
constexpr size_t O_KS0 = O_KP2 + (size_t)4 * 2048 * 2048;
constexpr size_t O_KS1 = O_KS0 + (size_t)32 * 128 * 2048;
constexpr size_t O_KS2 = O_KS1 + (size_t)32 * 512 * 2048;
constexpr size_t O_END = O_KS2 + (size_t)32 * 2048 * 2048;

constexpr size_t MiB = 1u << 20;
constexpr size_t WS_CTL = 0, CTL_BYTES = 1 * MiB, SS_OFF = 65536;
constexpr size_t WS_CS = 1 * MiB;
constexpr size_t WS_WIN = 3 * MiB, WS_WOUT = 11 * MiB, WS_WGU = 15 * MiB, WS_WDN = 59 * MiB, WS_WQKV = 81 * MiB, WS_WQ2 = 99 * MiB, WS_WO = 105 * MiB;
constexpr size_t WS_XB = 109 * MiB, WS_GLU = 142 * MiB, WS_HB = 175 * MiB, WS_ACT = 208 * MiB, WS_QB = 298 * MiB, WS_KB = 396 * MiB, WS_VB = 494 * MiB;
constexpr size_t WS_OG = 592 * MiB, WS_LSE = 690 * MiB, WS_KC = 694 * MiB, WS_END = 1036 * MiB;
constexpr size_t KC_OFF1 = (size_t)32 * 136 * 2048, KC_OFF2 = KC_OFF1 + (size_t)32 * 520 * 2048, KC_ELEMS = KC_OFF2 + (size_t)32 * 2056 * 2048;
static_assert(WS_KC + KC_ELEMS * 2 <= WS_END, "KC fits");
constexpr int LDS_BYTES = 135168;

struct Params { const float* in[25]; float* out; unsigned char* ws; int ph_lo, ph_hi; };

__device__ __forceinline__ unsigned pk2(float lo, float hi) { f32x2 v = {lo, hi}; bf16x2_t b = __builtin_convertvector(v, bf16x2_t); return __builtin_bit_cast(unsigned, b); }
__device__ __forceinline__ float bflo(unsigned u) { return __uint_as_float(u << 16); }
__device__ __forceinline__ float bfhi(unsigned u) { return __uint_as_float(u & 0xffff0000u); }
__device__ __forceinline__ float sigmoidf_(float x) { return __builtin_amdgcn_rcpf(1.f + __expf(-x)); }
__device__ __forceinline__ float wave_sum(float v) {
#pragma unroll
    for (int o = 1; o < 64; o <<= 1) v += __shfl_xor(v, o);
    return v;
}
template <int CTRL, int RM> __device__ __forceinline__ float dpp_f(float v) { return __int_as_float(__builtin_amdgcn_update_dpp(0, __float_as_int(v), CTRL, RM, 0xF, false)); }
__device__ __forceinline__ float wave_sum_dpp(float v) {
    v += dpp_f<0xB1, 0xF>(v);
    v += dpp_f<0x4E, 0xF>(v);
    v += dpp_f<0x141, 0xF>(v);
    v += dpp_f<0x140, 0xF>(v);
    v += dpp_f<0x142, 0xA>(v);
    v += dpp_f<0x143, 0xC>(v);
    return __int_as_float(__builtin_amdgcn_readlane(__float_as_int(v), 63));
}
template <int CTRL, int RM> __device__ __forceinline__ float dpp_keep(float v) { return __int_as_float(__builtin_amdgcn_update_dpp(__float_as_int(v), __float_as_int(v), CTRL, RM, 0xF, false)); }
__device__ __forceinline__ float wave_max_dpp(float v) {
    v = fmaxf(v, dpp_keep<0xB1, 0xF>(v)); v = fmaxf(v, dpp_keep<0x4E, 0xF>(v)); v = fmaxf(v, dpp_keep<0x141, 0xF>(v)); v = fmaxf(v, dpp_keep<0x140, 0xF>(v));
    v = fmaxf(v, dpp_keep<0x142, 0xA>(v)); v = fmaxf(v, dpp_keep<0x143, 0xC>(v));
    return __int_as_float(__builtin_amdgcn_readlane(__float_as_int(v), 63));
}
__device__ __forceinline__ float xrow16_sum(float x) {
    auto s = __builtin_amdgcn_permlane16_swap(__float_as_uint(x), __float_as_uint(x), false, false);
    x = __uint_as_float(s[0]) + __uint_as_float(s[1]);
    auto t = __builtin_amdgcn_permlane32_swap(__float_as_uint(x), __float_as_uint(x), false, false);
    return __uint_as_float(t[0]) + __uint_as_float(t[1]);
}
__device__ __forceinline__ float half_swap_sum(float x) { auto t = __builtin_amdgcn_permlane32_swap(__float_as_uint(x), __float_as_uint(x), false, false); return __uint_as_float(t[0]) + __uint_as_float(t[1]); }
__device__ __forceinline__ float half_swap_max(float x) { auto t = __builtin_amdgcn_permlane32_swap(__float_as_uint(x), __float_as_uint(x), false, false); return fmaxf(__uint_as_float(t[0]), __uint_as_float(t[1])); }
__device__ __forceinline__ float wave_max(float v) {
#pragma unroll
    for (int o = 1; o < 64; o <<= 1) v = fmaxf(v, __shfl_xor(v, o));
    return v;
}
__device__ __forceinline__ u32x4 pack8(f32x4 a, f32x4 b) { u32x4 w; w.x = pk2(a[0], a[1]); w.y = pk2(a[2], a[3]); w.z = pk2(b[0], b[1]); w.w = pk2(b[2], b[3]); return w; }

namespace pg8 {
constexpr int BM = 256, BK = 64, HALF = 128, HTB = HALF * BK * 2, NXCD = 8, WGM = 8;
__device__ __forceinline__ int lds_byte(int r, int c) { const int st = (r >> 4) * 2 + (c >> 5), rr = r & 15, cc = c & 31, ob = rr * 64 + cc * 2; return st * 1024 + (ob ^ (((ob >> 9) & 1) << 5)); }
__device__ __forceinline__ void stage_rc(int b, int& R, int& C) { const int st = b / 1024, sb = b % 1024, swz = sb ^ (((sb >> 9) & 1) << 5); R = (st >> 1) * 16 + swz / 64; C = (st & 1) * 32 + (swz % 64) / 2; }
__device__ __forceinline__ int perm32(int rho) { const int n = rho >> 4, i = rho & 15; return 8 * (i >> 2) + 4 * n + (i & 3); }
struct Unit { int pm, pn; };
struct Gemm { const bf16_t* A; const bf16_t* Bt; int M, N, K; };
struct StaticOrder {
    int nM, nN, nwg, G, c;
    __device__ void init(int M_, int N_, int G_, int c_) { nM = M_ / BM; nN = N_ / BM; nwg = nM * nN; G = G_; c = c_; }
    __device__ bool next(int i, Unit& u) const {
        if (c >= G) return false;
        const long L = (long)i * G + c; if (L >= nwg) return false;
        int wgid = (int)L; { const int q = nwg / NXCD, r = nwg % NXCD, xcd = wgid % NXCD, off = wgid / NXCD; wgid = (xcd < r ? xcd * (q + 1) : r * (q + 1) + (xcd - r) * q) + off; }
        const int nig = WGM * nN, gid = wgid / nig, fm = gid * WGM, gsz = (nM - fm) < WGM ? (nM - fm) : WGM;
        u.pm = fm + ((wgid % nig) % gsz); u.pn = (wgid % nig) / gsz; return true;
    }
};
template <class Epi>
__device__ __forceinline__ void gemm_phase(LAS unsigned char* lds, const Gemm g, const StaticOrder& S, const Epi& E) {
    const int tid = threadIdx.x, wid = __builtin_amdgcn_readfirstlane(tid >> 6), lane = tid & 63, wr = wid >> 2, wc = wid & 3, fr = lane & 15, fq = lane >> 4;
    const int K = g.K, nt = K / BK;
    unsigned voffA[2], voffB[2];
#pragma unroll
    for (int i = 0; i < 2; ++i) { int R, C; stage_rc(tid * 16 + i * 8192, R, C); const int Rb = (R & ~31) + perm32(R & 31);
        voffA[i] = (unsigned)(R * K + C) * 2u; voffB[i] = (unsigned)(Rb * K + C) * 2u; }
    const size_t kstep = (size_t)(BK * 2);
    const size_t hstep = (size_t)HALF * K * 2;
    const size_t tstep = 2 * hstep;
    const unsigned ldsw = (unsigned)wid * 1024u;
    const int aoff = lds_byte(wr * 64 + fr, fq * 8), boff = lds_byte(wc * 32 + fr, fq * 8);
#define PG8_SA(b, h) (((b) * 2 + (h)) * HTB)
#define PG8_SB(b, h) ((4 + (b) * 2 + (h)) * HTB)
#define PG8_STAGE(bufoff, gbase, voff) do { _Pragma("unroll") for (int _i = 0; _i < 2; ++_i) \
        __builtin_amdgcn_global_load_lds((const unsigned*)((const char*)(gbase) + (voff)[_i]), (LAS unsigned*)(lds + (bufoff) + ldsw + _i * 8192), 16, 0, 0); } while (0)
#define PG8_LDA(dst, b, h) do { _Pragma("unroll") for (int m = 0; m < 4; ++m) _Pragma("unroll") for (int k = 0; k < 2; ++k) dst[m][k] = *(const LAS bf16x8*)(lds + PG8_SA(b, h) + aoff + m * 2048 + k * 1024); } while (0)
#define PG8_LDB(dst, b, h) do { _Pragma("unroll") for (int n = 0; n < 2; ++n) _Pragma("unroll") for (int k = 0; k < 2; ++k) dst[n][k] = *(const LAS bf16x8*)(lds + PG8_SB(b, h) + boff + n * 2048 + k * 1024); } while (0)
#define PG8_MMA(ai, bj, At, Bt) do { __builtin_amdgcn_s_setprio(1); _Pragma("unroll") for (int m = 0; m < 4; ++m) _Pragma("unroll") for (int n = 0; n < 2; ++n) _Pragma("unroll") for (int k = 0; k < 2; ++k) \
        acc[ai][bj][m][n] = __builtin_amdgcn_mfma_f32_16x16x32_bf16(Bt[n][k], At[m][k], acc[ai][bj][m][n], 0, 0, 0); __builtin_amdgcn_s_setprio(0); } while (0)
#define PG8_WAIT_V(n) asm volatile("s_waitcnt vmcnt(" #n ")" ::: "memory")
#define PG8_WAIT_L(n) asm volatile("s_waitcnt lgkmcnt(" #n ")" ::: "memory")
#define PG8_BAR __builtin_amdgcn_s_barrier()
#define PG8_SCHED __builtin_amdgcn_sched_barrier(0)
    Unit cur, nxt; int ui = 0;
    if (!S.next(0, cur)) return;
    f32x4 acc[2][2][4][2];
#pragma unroll
    for (int a = 0; a < 2; ++a)
#pragma unroll
        for (int b = 0; b < 2; ++b)
#pragma unroll
            for (int m = 0; m < 4; ++m)
#pragma unroll
                for (int n = 0; n < 2; ++n) acc[a][b][m][n] = (f32x4){0.f, 0.f, 0.f, 0.f};
    bf16x8 At[4][2], B0[2][2], B1[2][2];
    const char* cA = (const char*)g.A + (size_t)cur.pm * tstep; const char* cB = (const char*)g.Bt + (size_t)cur.pn * tstep;
    PG8_STAGE(PG8_SB(0, 0), cB, voffB); PG8_STAGE(PG8_SB(0, 1), cB + hstep, voffB); PG8_STAGE(PG8_SA(0, 0), cA, voffA); PG8_STAGE(PG8_SA(0, 1), cA + hstep, voffA);
    if (wr == 1) PG8_BAR;
    PG8_WAIT_V(2); PG8_BAR;
    PG8_STAGE(PG8_SB(1, 0), cB + kstep, voffB); PG8_STAGE(PG8_SA(1, 0), cA + kstep, voffA); PG8_STAGE(PG8_SB(1, 1), cB + hstep + kstep, voffB);
    PG8_WAIT_V(6); PG8_BAR;
    for (;;) {
        const bool has_next = S.next(ui + 1, nxt);
        const char* nA = has_next ? (const char*)g.A + (size_t)nxt.pm * tstep : cA; const char* nB = has_next ? (const char*)g.Bt + (size_t)nxt.pn * tstep : cB;
        for (int t = 0; t < nt; t += 2) {
            const bool last = (t == nt - 2);
            const char* a1 = cA + (size_t)(t + 1) * kstep;
            const char* a2 = last ? nA : cA + (size_t)(t + 2) * kstep; const char* b2 = last ? nB : cB + (size_t)(t + 2) * kstep;
            const char* a3 = a2 + kstep; const char* b3 = b2 + kstep;
            PG8_LDB(B0, 0, 0); PG8_LDB(B1, 0, 1); PG8_SCHED; PG8_LDA(At, 0, 0); PG8_STAGE(PG8_SA(1, 1), a1 + hstep, voffA);
            PG8_WAIT_V(8); PG8_WAIT_L(0); PG8_BAR; PG8_MMA(0, 0, At, B0); PG8_MMA(0, 1, At, B1); PG8_BAR; PG8_SCHED;
            PG8_LDA(At, 0, 1); PG8_STAGE(PG8_SB(0, 0), b2, voffB); PG8_STAGE(PG8_SB(0, 1), b2 + hstep, voffB); PG8_STAGE(PG8_SA(0, 0), a2, voffA);
            PG8_WAIT_V(8); PG8_WAIT_L(0); PG8_BAR; PG8_MMA(1, 0, At, B0); PG8_MMA(1, 1, At, B1); PG8_BAR; PG8_SCHED;
            PG8_LDB(B0, 1, 0); PG8_LDB(B1, 1, 1); PG8_SCHED; PG8_LDA(At, 1, 0); PG8_STAGE(PG8_SA(0, 1), a2 + hstep, voffA);
            PG8_WAIT_V(8); PG8_WAIT_L(0); PG8_BAR; PG8_MMA(0, 0, At, B0); PG8_MMA(0, 1, At, B1); PG8_BAR; PG8_SCHED;
            PG8_LDA(At, 1, 1); PG8_STAGE(PG8_SB(1, 0), b3, voffB); PG8_STAGE(PG8_SB(1, 1), b3 + hstep, voffB); PG8_STAGE(PG8_SA(1, 0), a3, voffA);
            PG8_WAIT_V(8); PG8_WAIT_L(0); PG8_BAR; PG8_MMA(1, 0, At, B0); PG8_MMA(1, 1, At, B1); PG8_BAR; PG8_SCHED;
        }
        if (wr == 0) PG8_BAR;
        E(acc, cur, wr, wc, fr, fq);
        if (!has_next) break;
#pragma unroll
        for (int a = 0; a < 2; ++a)
#pragma unroll
            for (int b = 0; b < 2; ++b)
#pragma unroll
                for (int m = 0; m < 4; ++m)
#pragma unroll
                    for (int n = 0; n < 2; ++n) acc[a][b][m][n] = (f32x4){0.f, 0.f, 0.f, 0.f};
        cur = nxt; cA = nA; cB = nB; ++ui;
        if (wr == 1) PG8_BAR;
    }
    PG8_WAIT_V(0);
    PG8_BAR;
#undef PG8_SA
#undef PG8_SB
#undef PG8_STAGE
#undef PG8_LDA
#undef PG8_LDB
#undef PG8_MMA
#undef PG8_WAIT_V
#undef PG8_WAIT_L
#undef PG8_BAR
#undef PG8_SCHED
}
}
using pg8::Unit;

struct EpiGLU {
    bf16_t* G; const float* ss; const float* bias; float* cs_p; float* cs_s;
    __device__ __forceinline__ void operator()(const f32x4 (&acc)[2][2][4][2], const Unit& u, int wr, int wc, int fr, int fq) const {
#ifdef SKIP_EPIGLU
        return;
#endif
        const int ocol = u.pn * 128 + wc * 32 + fq * 8;
        f32x4 bv[2][2];
#pragma unroll
        for (int bj = 0; bj < 2; ++bj)
#pragma unroll
            for (int n = 0; n < 2; ++n) bv[bj][n] = *(const f32x4*)(bias + bj * D + ocol + 4 * n);
        float rsv[8];
#pragma unroll
        for (int q8 = 0; q8 < 8; ++q8) rsv[q8] = ss[u.pm * 256 + (q8 >> 2) * 128 + wr * 64 + (q8 & 3) * 16 + fr];
#pragma unroll
        for (int q8 = 0; q8 < 8; ++q8) rsv[q8] = rsqrtf(rsv[q8] * (1.f / D) + EPS);
#pragma unroll
        for (int ai = 0; ai < 2; ++ai)
#pragma unroll
            for (int m = 0; m < 4; ++m) {
                const int row = u.pm * 256 + ai * 128 + wr * 64 + m * 16 + fr;
                const float rs = rsv[ai * 4 + m];
                f32x4 o[2];
#pragma unroll
                for (int n = 0; n < 2; ++n) {
                    const f32x4 v = acc[ai][0][m][n] * rs + bv[0][n], gt = acc[ai][1][m][n] * rs + bv[1][n];
#pragma unroll
                    for (int j = 0; j < 4; ++j) o[n][j] = v[j] * sigmoidf_(gt[j]);
                }
                *(u32x4*)(G + (size_t)row * D + ocol) = pack8(o[0], o[1]);
                float* cs = nullptr;
                if (row < MP) { const int t = row & (SEQ - 1); if (t >= SEQ - 30) cs = cs_p + ((size_t)(row >> 12) * 30 + (t - (SEQ - 30))) * D; }
                else { const int rsr = row - MP; cs = cs_s + ((size_t)(rsr >> 3) * 30 + 22 + (rsr & 7)) * D; }
                if (cs) { __builtin_nontemporal_store(o[0], (f32x4*)(cs + ocol)); __builtin_nontemporal_store(o[1], (f32x4*)(cs + ocol + 4)); }
            }
    }
};
struct EpiRes {
    const float* xold_p; const float* xold_s; float* xnew; bf16_t* xb; const float* bias; float* ss_out;
    __device__ __forceinline__ void operator()(const f32x4 (&acc)[2][2][4][2], const Unit& u, int wr, int wc, int fr, int fq) const {
#ifdef SKIP_EPIRES
        return;
#endif
        const int col0 = u.pn * 256 + wc * 32 + fq * 8;
        f32x4 bv[2][2];
#pragma unroll
        for (int bj = 0; bj < 2; ++bj)
#pragma unroll
            for (int n = 0; n < 2; ++n) bv[bj][n] = bias ? *(const f32x4*)(bias + col0 + bj * 128 + 4 * n) : (f32x4){0.f, 0.f, 0.f, 0.f};
        f32x4 xc[2][2], xn[2][2];
        {
            const int row = u.pm * 256 + wr * 64 + fr;
            const float* xo = row < MP ? xold_p + (size_t)row * D : xold_s + (size_t)(row - MP) * D;
#pragma unroll
            for (int bj = 0; bj < 2; ++bj) { xc[bj][0] = *(const f32x4*)(xo + col0 + bj * 128); xc[bj][1] = *(const f32x4*)(xo + col0 + bj * 128 + 4); }
        }
#pragma unroll
        for (int q8 = 0; q8 < 8; ++q8) {
            const int ai = q8 >> 2, m = q8 & 3;
            const int row = u.pm * 256 + ai * 128 + wr * 64 + m * 16 + fr;
            if (q8 < 7) {
                const int rown = u.pm * 256 + ((q8 + 1) >> 2) * 128 + wr * 64 + ((q8 + 1) & 3) * 16 + fr;
                const float* xo = rown < MP ? xold_p + (size_t)rown * D : xold_s + (size_t)(rown - MP) * D;
#pragma unroll
                for (int bj = 0; bj < 2; ++bj) { xn[bj][0] = *(const f32x4*)(xo + col0 + bj * 128); xn[bj][1] = *(const f32x4*)(xo + col0 + bj * 128 + 4); }
            }
            float sq = 0.f;
#pragma unroll
            for (int bj = 0; bj < 2; ++bj) {
                const int c = col0 + bj * 128;
                const f32x4 x0 = xc[bj][0] + acc[ai][bj][m][0] + bv[bj][0], x1 = xc[bj][1] + acc[ai][bj][m][1] + bv[bj][1];
                *(f32x4*)(xnew + (size_t)row * D + c) = x0; *(f32x4*)(xnew + (size_t)row * D + c + 4) = x1;
                *(u32x4*)(xb + (size_t)row * D + c) = pack8(x0, x1);
#pragma unroll
                for (int j = 0; j < 4; ++j) sq += x0[j] * x0[j] + x1[j] * x1[j];
            }
            sq = xrow16_sum(sq);
            if (ss_out && fq == 0) atomicAdd(ss_out + row, sq);
#pragma unroll
            for (int bj = 0; bj < 2; ++bj) { xc[bj][0] = xn[bj][0]; xc[bj][1] = xn[bj][1]; }
        }
    }
};
struct EpiSwiGLU {
    bf16_t* A; const float* ss;
    __device__ __forceinline__ void operator()(const f32x4 (&acc)[2][2][4][2], const Unit& u, int wr, int wc, int fr, int fq) const {
#ifdef SKIP_EPISWIGLU
        return;
#endif
        const int ocol = u.pn * 128 + wc * 32 + fq * 8;
        float rsv[8];
#pragma unroll
        for (int q8 = 0; q8 < 8; ++q8) rsv[q8] = ss[u.pm * 256 + (q8 >> 2) * 128 + wr * 64 + (q8 & 3) * 16 + fr];
#pragma unroll
        for (int q8 = 0; q8 < 8; ++q8) rsv[q8] = rsqrtf(rsv[q8] * (1.f / D) + EPS);
#pragma unroll
        for (int ai = 0; ai < 2; ++ai)
#pragma unroll
            for (int m = 0; m < 4; ++m) {
                const int row = u.pm * 256 + ai * 128 + wr * 64 + m * 16 + fr;
                const float rs = rsv[ai * 4 + m];
                f32x4 o[2];
#pragma unroll
                for (int n = 0; n < 2; ++n) {
                    const f32x4 gt = acc[ai][0][m][n] * rs, up = acc[ai][1][m][n] * rs;
#pragma unroll
                    for (int j = 0; j < 4; ++j) o[n][j] = gt[j] * sigmoidf_(gt[j]) * up[j];
                }
                *(u32x4*)(A + (size_t)row * FF + ocol) = pack8(o[0], o[1]);
            }
    }
};
template <int J> struct EpiQKV {
    unsigned char* ws; const float* k_norm; const float* q_norm; float* out;
    __device__ __forceinline__ void operator()(const f32x4 (&acc)[2][2][4][2], const Unit& u, int wr, int wc, int fr, int fq) const {
#ifdef SKIP_EPIQKV
        return;
#endif
        const int pn = u.pn + (J == 0 ? 0 : 24);
        const float* ss = (const float*)(ws + WS_CTL + SS_OFF) + (size_t)(4 + 2 * J) * M;
        bf16_t* QB = (bf16_t*)(ws + WS_QB); bf16_t* KB = (bf16_t*)(ws + WS_KB); bf16_t* VB = (bf16_t*)(ws + WS_VB); const float* CS = (const float*)(ws + WS_CS);
        const bool is_q = pn >= 24;
        int g, kvsel = 0, hq;
        if (!is_q) { g = pn >> 3; kvsel = (pn >> 2) & 1; hq = pn & 3; } else { const int pq = pn - 24; g = pq >> 2; hq = pq & 3; }
        const int h = hq * 4 + wc, dlo = fq * 8;
        const bool do_norm = is_q || kvsel == 0;
        f32x4 gv[2][2];
#pragma unroll
        for (int bj = 0; bj < 2; ++bj)
#pragma unroll
            for (int n = 0; n < 2; ++n) gv[bj][n] = *(const f32x4*)((is_q ? q_norm : k_norm) + g * 64 + bj * 32 + dlo + 4 * n);
        bf16_t* dstb = (is_q ? QB : (kvsel ? VB : KB)) + g * 1024 + h * 64 + dlo;
        const int lg = 128 << (2 * g);
        float* kvp = out + (g == 0 ? O_KP0 : (g == 1 ? O_KP1 : O_KP2));
        float* kvs = out + (g == 0 ? O_KS0 : (g == 1 ? O_KS1 : O_KS2));
        float rsv[8];
#pragma unroll
        for (int q8 = 0; q8 < 8; ++q8) rsv[q8] = ss[u.pm * 256 + (q8 >> 2) * 128 + wr * 64 + (q8 & 3) * 16 + fr];
#pragma unroll
        for (int q8 = 0; q8 < 8; ++q8) rsv[q8] = rsqrtf(rsv[q8] * (1.f / D) + EPS);
        f32x4 cur[4], d16[4];
        {
            const int row0 = u.pm * 256 + wr * 64 + fr;
            const int pidx0 = row0 < MP ? (row0 & (SEQ - 1)) : SEQ + ((row0 - MP) & 7);
            const bool smp = u.pm * 256 >= MP;
#pragma unroll
            for (int q4 = 0; q4 < 4; ++q4) {
                cur[q4] = do_norm ? *((const f32x4*)(CS + ((size_t)pidx0 * 32 + dlo) * 2) + q4) : (f32x4){1.f, 0.f, 1.f, 0.f};
                d16[q4] = (do_norm && !smp) ? *((const f32x4*)(CS + ((size_t)16 * 32 + dlo) * 2) + q4) : (f32x4){1.f, 0.f, 1.f, 0.f};
            }
        }
#pragma unroll
        for (int ai = 0; ai < 2; ++ai) {
#pragma unroll
            for (int m = 0; m < 4; ++m) {
                const int row = u.pm * 256 + ai * 128 + wr * 64 + m * 16 + fr;
                const float rs = rsv[ai * 4 + m];
                f32x4 v[2][2];
#pragma unroll
                for (int bj = 0; bj < 2; ++bj)
#pragma unroll
                    for (int n = 0; n < 2; ++n) v[bj][n] = acc[ai][bj][m][n] * rs;
                if (do_norm) {
                    float sq = 0.f;
#pragma unroll
                    for (int bj = 0; bj < 2; ++bj)
#pragma unroll
                        for (int n = 0; n < 2; ++n)
#pragma unroll
                            for (int j = 0; j < 4; ++j) sq += v[bj][n][j] * v[bj][n][j];
                    sq = xrow16_sum(sq);
                    const float hr = rsqrtf(sq * (1.f / 64.f) + EPS);
                    const f32x4* csp = cur;
                    const float sc = is_q ? QSCALE : 1.f;
#pragma unroll
                    for (int n = 0; n < 2; ++n) {
                        const f32x4 y1 = v[0][n] * hr * gv[0][n], y2 = v[1][n] * hr * gv[1][n];
                        const f32x4 c01 = csp[2 * n], c23 = csp[2 * n + 1];
                        const float cs_[4] = {c01[0], c01[2], c23[0], c23[2]}, sn_[4] = {c01[1], c01[3], c23[1], c23[3]};
#pragma unroll
                        for (int j = 0; j < 4; ++j) { v[0][n][j] = (y1[j] * cs_[j] - y2[j] * sn_[j]) * sc; v[1][n][j] = (y2[j] * cs_[j] + y1[j] * sn_[j]) * sc; }
                    }
                }
                *(u32x4*)(dstb + (size_t)row * GH) = pack8(v[0][0], v[0][1]);
                *(u32x4*)(dstb + (size_t)row * GH + 32) = pack8(v[1][0], v[1][1]);
                if (!is_q) {
                    float* dst = nullptr;
                    if (row < MP) { const int t = row & (SEQ - 1), i = t - (SEQ - lg); if (i >= 0) dst = kvp + (((size_t)(row >> 12) * lg + i) * 2 + kvsel) * 1024 + h * 64 + dlo; }
                    else { const int rsr = row - MP; dst = kvs + (((size_t)(rsr >> 3) * lg + lg - 8 + (rsr & 7)) * 2 + kvsel) * 1024 + h * 64 + dlo;
                        bf16_t* kc = (bf16_t*)(ws + WS_KC) + (g == 0 ? 0 : (g == 1 ? KC_OFF1 : KC_OFF2)) + (((size_t)(rsr >> 3) * (lg + 8) + lg + (rsr & 7)) * 2 + kvsel) * 1024 + h * 64 + dlo;
                        *(u32x4*)kc = pack8(v[0][0], v[0][1]); *(u32x4*)(kc + 32) = pack8(v[1][0], v[1][1]); }
                    if (dst) { __builtin_nontemporal_store(v[0][0], (f32x4*)dst); __builtin_nontemporal_store(v[0][1], (f32x4*)(dst + 4)); __builtin_nontemporal_store(v[1][0], (f32x4*)(dst + 32)); __builtin_nontemporal_store(v[1][1], (f32x4*)(dst + 36)); }
                }
                if (do_norm && !(ai == 1 && m == 3)) {
#pragma unroll
                    for (int rep = 0; rep < ((m == 3) ? 5 : 1); ++rep)
#pragma unroll
                        for (int q4 = 0; q4 < 4; ++q4) { const f32x4 a = cur[q4], d = d16[q4]; cur[q4] = (f32x4){a[0] * d[0] - a[1] * d[1], a[1] * d[0] + a[0] * d[1], a[2] * d[2] - a[3] * d[3], a[3] * d[2] + a[2] * d[3]}; }
                }
            }
        }
    }
};

constexpr unsigned COPY_G0 = 32u * 120u * 512u, COPY_G1 = 32u * 504u * 512u, COPY_G2 = 32u * 2040u * 512u;
constexpr unsigned COPY_TOTAL = COPY_G0 + COPY_G1 + COPY_G2, COPY_CHUNK = 8192u, COPY_NCHUNK1 = COPY_TOTAL / COPY_CHUNK;
static_assert(COPY_TOTAL % COPY_CHUNK == 0, "copy chunks");
__device__ __forceinline__ unsigned xb_ld(unsigned* p) { return __hip_atomic_load(p, __ATOMIC_RELAXED, __HIP_MEMORY_SCOPE_AGENT); }
__device__ __forceinline__ unsigned xb_add(unsigned* p, unsigned v) { return __hip_atomic_fetch_add(p, v, __ATOMIC_RELAXED, __HIP_MEMORY_SCOPE_AGENT); }
__device__ __forceinline__ unsigned xb_xcc_id() { return (unsigned)__builtin_amdgcn_s_getreg((3 << 11) | 20) & 0xFu; }
__device__ __forceinline__ void copy_decode(unsigned e, int& g, unsigned& Lb, unsigned& b, unsigned& rem) {
    if (e < COPY_G0) g = 0; else if (e < COPY_G0 + COPY_G1) { g = 1; e -= COPY_G0; } else { g = 2; e -= COPY_G0 + COPY_G1; }
    Lb = 128u << (2 * g); const unsigned per_b = (Lb - 8u) * 512u; b = e / per_b; rem = e - b * per_b;
}
__device__ __forceinline__ void copy_chunk(const float* s0, const float* s1, const float* s2, float* out, bf16_t* kcb, unsigned c) {
    f32x4 v[16];
#pragma unroll
    for (int k = 0; k < 16; ++k) {
        int g; unsigned Lb, b, rem; copy_decode(c * COPY_CHUNK + k * 512u + threadIdx.x, g, Lb, b, rem);
        const float* src = g == 0 ? s0 : (g == 1 ? s1 : s2);
        v[k] = __builtin_nontemporal_load((const f32x4*)(src + ((size_t)b * Lb + 8) * 2048) + rem);
    }
#pragma unroll
    for (int k = 0; k < 16; ++k) {
        int g; unsigned Lb, b, rem; copy_decode(c * COPY_CHUNK + k * 512u + threadIdx.x, g, Lb, b, rem);
        float* dst = out + (g == 0 ? O_KS0 : (g == 1 ? O_KS1 : O_KS2));
        __builtin_nontemporal_store(v[k], (f32x4*)(dst + (size_t)b * Lb * 2048) + rem);
        u32x2 o; o.x = pk2(v[k][0], v[k][1]); o.y = pk2(v[k][2], v[k][3]);
        if (g != 2 || ((((rem >> 9) + 8u) & 15u) < 8u))
            *((u32x2*)(kcb + (g == 0 ? 0 : (g == 1 ? KC_OFF1 : KC_OFF2)) + ((size_t)b * (Lb + 8) + 8) * 2048) + rem) = o;
    }
}

__device__ __forceinline__ void transpose_item(const float* W, int ldw, int src_col0, const float* gain, bf16_t* WT, int K, int dst_row0, int k0, LAS float* scr, int lane) {
#pragma unroll
    for (int i = 0; i < 8; ++i) { const int kk = 8 * i + (lane >> 3), ch = lane & 7; const float gn = gain ? gain[k0 + kk] : 1.f;
        const f32x4 v = *(const f32x4*)(W + (size_t)(k0 + kk) * ldw + src_col0 + 4 * ch);
        scr[kk * 33 + 4 * ch] = v[0] * gn; scr[kk * 33 + 4 * ch + 1] = v[1] * gn; scr[kk * 33 + 4 * ch + 2] = v[2] * gn; scr[kk * 33 + 4 * ch + 3] = v[3] * gn; }
    asm volatile("s_waitcnt lgkmcnt(0)" ::: "memory");
    const int c = lane & 7;
#pragma unroll
    for (int j = 0; j < 4; ++j) { const int n = (lane >> 3) + 8 * j; const LAS float* s = scr + (8 * c) * 33 + n;
        u32x4 o; o.x = pk2(s[0 * 33], s[1 * 33]); o.y = pk2(s[2 * 33], s[3 * 33]); o.z = pk2(s[4 * 33], s[5 * 33]); o.w = pk2(s[6 * 33], s[7 * 33]);
        *(u32x4*)(WT + (size_t)(dst_row0 + n) * K + k0 + 8 * c) = o; }
    asm volatile("s_waitcnt lgkmcnt(0)" ::: "memory");
}
__device__ __forceinline__ void sincos_d(double a, float& c, float& s) {
    const double k = __builtin_rint(a * 0.63661977236758134308);
    const double y = __builtin_fma(-k, 1.5707963267948966192, a) - k * 6.123233995736766036e-17;
    const double y2 = y * y;
    double sp = -2.5052108385441718775e-8; sp = sp * y2 + 2.7557319223985890653e-6; sp = sp * y2 - 1.9841269841269841270e-4; sp = sp * y2 + 8.3333333333333333333e-3; sp = sp * y2 - 1.6666666666666666667e-1;
    const double sy = y + y * y2 * sp;
    double cp = 2.0876756987868098979e-9; cp = cp * y2 - 2.7557319223985890653e-7; cp = cp * y2 + 2.4801587301587301587e-5; cp = cp * y2 - 1.3888888888888888889e-3; cp = cp * y2 + 4.1666666666666666667e-2; cp = cp * y2 - 0.5;
    const double cy = 1.0 + y2 * cp;
    const int q = ((int)k) & 3;
    const double cc = (q == 0) ? cy : (q == 1) ? -sy : (q == 2) ? -cy : sy;
    const double ss = (q == 0) ? sy : (q == 1) ? cy : (q == 2) ? -sy : -cy;
    c = (float)cc; s = (float)ss;
}
__device__ __forceinline__ void copy_f4(const float* src, float* dst, size_t n4, size_t gt, size_t nthr) {
    const f32x4* s = (const f32x4*)src; f32x4* d = (f32x4*)dst;
    for (size_t i = gt; i < n4; i += nthr) __builtin_nontemporal_store(__builtin_nontemporal_load(s + i), d + i);
}
constexpr int I_WIN = 16 * 64, I_WOUT = 16 * 32, I_WGU = 16 * 176, I_WDN = 44 * 32, I_WQKV = 16 * 288, I_WQ2 = 16 * 96, I_WO = 16 * 32;
constexpr int NITEMS = 2 * I_WIN + 2 * I_WOUT + 4 * I_WGU + 4 * I_WDN + I_WQKV + I_WQ2 + 2 * I_WO;
__device__ __forceinline__ void weight_item(const Params& P, int it, LAS float* scr, int lane) {
    unsigned char* ws = P.ws;
        int r = it;
        if (r < 2 * I_WIN) { const int l = r / I_WIN; r -= l * I_WIN; const int kb = r / 64, nb = r % 64, pn = nb >> 3, bj = (nb >> 2) & 1, e = nb & 3;
            transpose_item(P.in[7] + (size_t)l * D * 2 * D, 2 * D, bj * D + 128 * pn + 32 * e, P.in[6] + l * D, (bf16_t*)(ws + WS_WIN) + (size_t)l * 2 * D * D, D, 32 * nb, 64 * kb, scr, lane); return; }
        r -= 2 * I_WIN;
        if (r < 2 * I_WOUT) { const int l = r / I_WOUT; r -= l * I_WOUT; const int kb = r / 32, nb = r % 32;
            transpose_item(P.in[13] + (size_t)l * D * D, D, 32 * nb, nullptr, (bf16_t*)(ws + WS_WOUT) + (size_t)l * D * D, D, 32 * nb, 64 * kb, scr, lane); return; }
        r -= 2 * I_WOUT;
        if (r < 4 * I_WGU) { const int l = r / I_WGU; r -= l * I_WGU; const int kb = r / 176, nb = r % 176, pn = nb >> 3, bj = (nb >> 2) & 1, e = nb & 3;
            transpose_item(P.in[23] + (size_t)l * D * 2 * FF, 2 * FF, bj * FF + 128 * pn + 32 * e, P.in[22] + l * D, (bf16_t*)(ws + WS_WGU) + (size_t)l * 2 * FF * D, D, 32 * nb, 64 * kb, scr, lane); return; }
        r -= 4 * I_WGU;
        if (r < 4 * I_WDN) { const int l = r / I_WDN; r -= l * I_WDN; const int kb = r / 32, nb = r % 32;
            transpose_item(P.in[24] + (size_t)l * FF * D, D, 32 * nb, nullptr, (bf16_t*)(ws + WS_WDN) + (size_t)l * D * FF, FF, 32 * nb, 64 * kb, scr, lane); return; }
        r -= 4 * I_WDN;
        if (r < I_WQKV) { const int kb = r / 288, nb = r % 288, pn = nb >> 3, bj = (nb >> 2) & 1, wc = nb & 3;
            if (pn < 24) { const int g = pn >> 3, kvsel = (pn >> 2) & 1, hq = pn & 3;
                transpose_item(P.in[16], 2 * GH, g * 2048 + kvsel * 1024 + (4 * hq + wc) * 64 + 32 * bj, P.in[15], (bf16_t*)(ws + WS_WQKV), D, 32 * nb, 64 * kb, scr, lane); }
            else { const int pq = pn - 24, g = pq >> 2, hq = pq & 3;
                transpose_item(P.in[19], GH, g * 1024 + (4 * hq + wc) * 64 + 32 * bj, P.in[18], (bf16_t*)(ws + WS_WQKV), D, 32 * nb, 64 * kb, scr, lane); }
            return; }
        r -= I_WQKV;
        if (r < I_WQ2) { const int kb = r / 96, nb = r % 96, pn = nb >> 3, bj = (nb >> 2) & 1, wc = nb & 3, g = pn >> 2, hq = pn & 3;
            transpose_item(P.in[19] + (size_t)D * GH, GH, g * 1024 + (4 * hq + wc) * 64 + 32 * bj, P.in[18] + D, (bf16_t*)(ws + WS_WQ2), D, 32 * nb, 64 * kb, scr, lane); return; }
        r -= I_WQ2;
        { const int l = r / I_WO; r -= l * I_WO; const int kb = r / 32, nb = r % 32;
            transpose_item(P.in[21] + (size_t)l * D * D, D, 32 * nb, nullptr, (bf16_t*)(ws + WS_WO) + (size_t)l * D * D, D, 32 * nb, 64 * kb, scr, lane); }
}
__device__ __forceinline__ int need_to_orig(int n) {
    if (n < 1024) return n;
    if (n < 1536) return n - 1024 + 2048;
    if (n < 4352) return n - 1536 + 3072;
    if (n < 5760) return n - 4352 + 14336;
    if (n < 6784) return n - 5760 + 1024;
    if (n < 7296) return n - 6784 + 2560;
    if (n < 10112) return n - 7296 + 5888;
    if (n < 11520) return n - 10112 + 15744;
    if (n < 16128) return n - 11520 + 19968;
    if (n < 16640) return n - 16128 + 26112;
    if (n < 19456) return n - 16640 + 8704;
    if (n < 20864) return n - 19456 + 17152;
    if (n < 22400) return n - 20864 + 24576;
    if (n < 22912) return n - 22400 + 26624;
    if (n < 25728) return n - 22912 + 11520;
    return n - 25728 + 18560;
}
constexpr unsigned QW1 = 2016u - 128u, QCP = QW1 + COPY_NCHUNK1, QTOT = QCP + (3392u - 2016u);
__device__ __noinline__ void work_item(const Params* Pp, unsigned q, LAS unsigned char* lds) {
    const Params& P = *Pp;
    if (q >= QW1 && q < QCP) { copy_chunk(P.in[3], P.in[4], P.in[5], P.out, (bf16_t*)(P.ws + WS_KC), q - QW1); return; }
    const int bi = q < QW1 ? 128 + (int)q : 2016 + (int)(q - QCP);
    const int lane = threadIdx.x & 63, wave = threadIdx.x >> 6;
    weight_item(P, need_to_orig(8 * bi + wave), (LAS float*)(lds + wave * 16384), lane);
}
__host__ __device__ constexpr unsigned work_need(int p) {
    return p <= 2 ? 0u : p == 3 ? 64u : p == 4 ? 416u : p == 5 ? 592u : p <= 7 ? 720u : p == 8 ? 784u : p == 9 ? 1136u : p == 10 ? 1312u : p == 11 ? 1888u
         : p <= 13 ? QCP : p == 14 ? QCP + 64u : p == 15 ? QCP + 416u : p == 16 ? QCP + 592u : p <= 19 ? QCP + 784u : p == 20 ? QCP + 848u : p == 21 ? QCP + 1200u : QTOT;
}
__device__ __forceinline__ void phase_prologue(const Params& P, LAS unsigned char* lds) {
    const int tid = threadIdx.x, lane = tid & 63, wave = tid >> 6;
    const int gw = blockIdx.x * 8 + wave, NGW = gridDim.x * 8;
    unsigned char* ws = P.ws;
    LAS float* scr = (LAS float*)(lds + wave * 16384);
    for (int it = gw; it < I_WIN; it += NGW) weight_item(P, it, scr, lane);
#if !ONE_LAUNCH
    { const Params* kp = (const Params*)__builtin_amdgcn_kernarg_segment_ptr(); for (unsigned q = blockIdx.x; q < QTOT; q += gridDim.x) work_item(kp, q, lds); }
#endif
    {
        bf16_t* XB = (bf16_t*)(ws + WS_XB); float* ss0 = (float*)(ws + WS_CTL + SS_OFF);
        for (int m0 = gw; m0 < M; m0 += 4 * NGW) {
            f32x4 v[4][4];
#pragma unroll
            for (int k = 0; k < 4; ++k) { int m = m0 + k * NGW; if (m >= M) m = m0;
                const float* xr = m < MP ? P.in[0] + (size_t)m * D : P.in[1] + (size_t)(m - MP) * D;
#pragma unroll
                for (int j = 0; j < 4; ++j) v[k][j] = *((const f32x4*)xr + lane + 64 * j); }
#pragma unroll
            for (int k = 0; k < 4; ++k) { const int m = m0 + k * NGW; if (m >= M) continue;
                float sm = 0.f;
#pragma unroll
                for (int j = 0; j < 4; ++j) { const f32x4 w = v[k][j]; sm += w[0] * w[0] + w[1] * w[1] + w[2] * w[2] + w[3] * w[3];
                    u32x2 o; o.x = pk2(w[0], w[1]); o.y = pk2(w[2], w[3]); *((u32x2*)(XB + (size_t)m * D) + lane + 64 * j) = o; }
                sm = wave_sum_dpp(sm);
                if (lane == 0) ss0[m] = sm; }
        }
    }
    const size_t gt = (size_t)blockIdx.x * 512 + tid, nthr = (size_t)gridDim.x * 512;
    {
        float* CS = (float*)(ws + WS_CS);
        for (size_t e = gt; e < (size_t)(SEQ + 8) * 32; e += nthr) {
            const int pi = (int)(e >> 5), i = (int)(e & 31); const int pos = pi < SEQ ? pi : 8192 + (pi - SEQ);
            const float invf = (float)exp2(-(double)i * (13.287712379549449 / 32.0));
            float c, s; sincos_d((double)pos * (double)invf, c, s);
            CS[2 * e] = c; CS[2 * e + 1] = s;
        }
    }
    for (size_t e = gt; e < (size_t)2 * 32 * 22 * 256; e += nthr) {
        const size_t lb = e / (22 * 256), rem = e % (22 * 256);
        ((f32x4*)(P.out + O_CS + lb * 30 * D))[rem] = ((const f32x4*)(P.in[2] + lb * 30 * D + 8 * D))[rem];
    }
    for (size_t e = gt; e < (size_t)3 * 32 * 8 * 512; e += nthr) {
        const int g = (int)(e / (32 * 8 * 512)); const size_t r2 = e % (32 * 8 * 512), b = r2 / (8 * 512), rem = r2 % (8 * 512);
        const int Lb = 128 << (2 * g);
        const f32x4 v = *((const f32x4*)(P.in[3 + g] + b * Lb * 2048) + rem);
        u32x2 o; o.x = pk2(v[0], v[1]); o.y = pk2(v[2], v[3]);
        *((u32x2*)((bf16_t*)(ws + WS_KC) + (g == 0 ? 0 : (g == 1 ? KC_OFF1 : KC_OFF2)) + b * (Lb + 8) * 2048) + rem) = o;
    }
}

__device__ __forceinline__ void phase_conv(const Params& P, LAS unsigned char* lds, int layer) {
    const int tid = threadIdx.x, lane = tid & 63, wave = tid >> 6, c0 = 2 * tid;
    const bf16_t* GLU = (const bf16_t*)(P.ws + WS_GLU); bf16_t* HB = (bf16_t*)(P.ws + WS_HB);
    const float* wdw = P.in[9] + (size_t)layer * 31 * D;
    float w0[31], w1[31];
#pragma unroll
    for (int w = 0; w < 31; ++w) { const f32x2 ww = *(const f32x2*)(wdw + w * D + c0); w0[w] = ww[0]; w1[w] = ww[1]; }
    const f32x2 bdw = *(const f32x2*)(P.in[10] + layer * D + c0), lng = *(const f32x2*)(P.in[11] + layer * D + c0), lnb = *(const f32x2*)(P.in[12] + layer * D + c0);
    LAS float* red = (LAS float*)(lds + 62 * 2048);
    for (int u = blockIdx.x; u < 544; u += gridDim.x) {
        const bool sample = u >= 512;
        const int b = sample ? u - 512 : u >> 7, t0 = sample ? 0 : (u & 127) * 32, nstep = sample ? 1 : 4;
        const size_t rowbase = sample ? (size_t)MP + b * 8 : (size_t)b * SEQ;
        __syncthreads();
        if (!sample) {
#pragma unroll
            for (int k = 0; k < 16; ++k) { const int q = tid + 512 * k, rr = q >> 7, part = q & 127, grow = t0 - 30 + rr;
                if (q < 62 * 128) { u32x4 v = {0u, 0u, 0u, 0u}; if (grow >= 0) v = *(const u32x4*)(GLU + (rowbase + grow) * D + part * 8); *(LAS u32x4*)(lds + rr * 2048 + part * 16) = v; } }
        } else {
            const float* prev = P.in[2] + (size_t)(layer * 32 + b) * 30 * D;
#pragma unroll
            for (int k = 0; k < 10; ++k) { const int q = tid + 512 * k, rr = q >> 7, part = q & 127;
                if (q < 38 * 128) { u32x4 v;
                    if (rr < 30) { const f32x4 f0 = *(const f32x4*)(prev + (size_t)rr * D + part * 8), f1 = *(const f32x4*)(prev + (size_t)rr * D + part * 8 + 4); v = pack8(f0, f1); }
                    else v = *(const u32x4*)(GLU + (rowbase + rr - 30) * D + part * 8);
                    *(LAS u32x4*)(lds + rr * 2048 + part * 16) = v; } }
        }
        __syncthreads();
        for (int st = 0; st < nstep; ++st) {
            float a0[8], a1[8];
#pragma unroll
            for (int tt = 0; tt < 8; ++tt) { a0[tt] = bdw[0]; a1[tt] = bdw[1]; }
            const LAS unsigned char* lp = lds + (8 * st) * 2048 + tid * 4;
#pragma unroll
            for (int i = 0; i < 38; ++i) {
                const unsigned v = *(const LAS unsigned*)(lp + i * 2048);
                const float g0 = bflo(v), g1 = bfhi(v);
#pragma unroll
                for (int tt = 0; tt < 8; ++tt) { const int w = i - tt; if (w >= 0 && w <= 30) { a0[tt] += w0[w] * g0; a1[tt] += w1[w] * g1; } }
            }
            float s1[8], s2[8];
#pragma unroll
            for (int tt = 0; tt < 8; ++tt) { s1[tt] = wave_sum_dpp(a0[tt] + a1[tt]); s2[tt] = wave_sum_dpp(a0[tt] * a0[tt] + a1[tt] * a1[tt]); }
            if (lane == 0) {
#pragma unroll
                for (int tt = 0; tt < 8; ++tt) { red[wave * 16 + 2 * tt] = s1[tt]; red[wave * 16 + 2 * tt + 1] = s2[tt]; }
            }
            __syncthreads();
            if (tid < 16) { float sm = 0.f;
#pragma unroll
                for (int w = 0; w < 8; ++w) sm += red[w * 16 + tid];
                red[128 + tid] = sm; }
            __syncthreads();
#pragma unroll
            for (int tt = 0; tt < 8; ++tt) {
                const float mean = red[128 + 2 * tt] * (1.f / D), var = red[128 + 2 * tt + 1] * (1.f / D) - mean * mean, rstd = rsqrtf(var + EPS);
                const float y0 = (a0[tt] - mean) * rstd * lng[0] + lnb[0], y1 = (a1[tt] - mean) * rstd * lng[1] + lnb[1];
                *(unsigned*)(HB + (rowbase + t0 + 8 * st + tt) * D + c0) = pk2(y0 * sigmoidf_(y0), y1 * sigmoidf_(y1));
            }
        }
    }
    __syncthreads();
}

constexpr int KSTR = 144, VSTR = 192, LDS_V = 384 * KSTR;
static_assert(LDS_V + 384 * VSTR <= 131072, "attention LDS");
struct AttnRegs { u32x4 kv[6], vv[6]; bf16x8 qf[4]; };
__device__ __forceinline__ void attn_decode(int u, int& g, int& r, int& rho, int& h, int& b, int& l0) {
    g = u >> 10; const int rem = u & 1023;
    r = 1 << (2 * g); const int nblk = 16 >> (2 * g);
    const int blk = rem & (nblk - 1); rho = (rem >> (4 - 2 * g)) & (r - 1); h = (rem >> 4) & 15; b = rem >> 8;
    l0 = blk * 256;
}
__device__ __forceinline__ void attn_prompt_load(int u, AttnRegs& R, const bf16_t* QB, const bf16_t* KB, const bf16_t* VB) {
    const int tid = threadIdx.x, lane = tid & 63, w = __builtin_amdgcn_readfirstlane(tid >> 6), l32 = lane & 31, hh = lane >> 5;
    int g, r, rho, h, b, l0; attn_decode(u, g, r, rho, h, b, l0);
    const size_t colbase = (size_t)g * 1024 + h * 64;
#pragma unroll
    for (int c = 0; c < 6; ++c) {
        const int chunk = tid + 512 * c, key = chunk >> 3, part = chunk & 7, l = l0 - 128 + key;
        R.kv[c] = (u32x4){0u, 0u, 0u, 0u}; R.vv[c] = (u32x4){0u, 0u, 0u, 0u};
        if (l >= 0) { const size_t off = ((size_t)b * SEQ + (size_t)l * r + rho) * GH + colbase + part * 8; R.kv[c] = *(const u32x4*)(KB + off); R.vv[c] = *(const u32x4*)(VB + off); }
    }
    const size_t qrow = (size_t)b * SEQ + (size_t)(l0 + 32 * w + l32) * r + rho;
#pragma unroll
    for (int ks = 0; ks < 4; ++ks) R.qf[ks] = *(const bf16x8*)(QB + qrow * GH + colbase + 16 * ks + 8 * hh);
}
__device__ __forceinline__ void attn_prompt_stage(LAS unsigned char* lds, const AttnRegs& R) {
    const int tid = threadIdx.x;
#pragma unroll
    for (int c = 0; c < 6; ++c) {
        const int chunk = tid + 512 * c, key = chunk >> 3, part = chunk & 7;
        *(LAS u32x4*)(lds + key * KSTR + part * 16) = R.kv[c]; *(LAS u32x4*)(lds + LDS_V + key * VSTR + part * 16) = R.vv[c];
    }
}
__device__ __forceinline__ void attn_prompt_compute(LAS unsigned char* lds, int u, const bf16x8 (&qf)[4], bf16_t* OG, float* LSE) {
    const int tid = threadIdx.x, lane = tid & 63, w = __builtin_amdgcn_readfirstlane(tid >> 6), l32 = lane & 31, hh = lane >> 5;
    int g, r, rho, h, b, l0; attn_decode(u, g, r, rho, h, b, l0);
    const size_t qrow = (size_t)b * SEQ + (size_t)(l0 + 32 * w + l32) * r + rho;
    f32x16 s[5];
    {
        const LAS unsigned char* kbase = lds + (32 * w + l32) * KSTR + hh * 16;
        bf16x8 ka[2][4];
#pragma unroll
        for (int ks = 0; ks < 4; ++ks) ka[0][ks] = *(const LAS bf16x8*)(kbase + ks * 32);
#pragma unroll
        for (int kb = 0; kb < 5; ++kb) {
            if (kb < 4) {
#pragma unroll
                for (int ks = 0; ks < 4; ++ks) ka[(kb + 1) & 1][ks] = *(const LAS bf16x8*)(kbase + (32 * (kb + 1)) * KSTR + ks * 32);
            }
            __builtin_amdgcn_sched_barrier(0);
#pragma unroll
            for (int i = 0; i < 16; ++i) s[kb][i] = 0.f;
#pragma unroll
            for (int ks = 0; ks < 4; ++ks) s[kb] = __builtin_amdgcn_mfma_f32_32x32x16_bf16(ka[kb & 1][ks], qf[ks], s[kb], 0, 0, 0);
            __builtin_amdgcn_sched_barrier(0);
        }
    }
    {
        const int d0 = 4 * hh - l32;
#pragma unroll
        for (int i = 0; i < 16; ++i) { const int xi = 8 * (i >> 2) + (i & 3);
            s[0][i] = (xi + d0 >= 0) ? s[0][i] : -3.0e38f;
            s[4][i] = (xi + d0 <= 0) ? s[4][i] : -3.0e38f; }
        if (l0 == 0 && w < 4) {
            const int k0 = 32 * w + 4 * hh - 128;
#pragma unroll
            for (int kb = 0; kb < 4; ++kb)
#pragma unroll
                for (int i = 0; i < 16; ++i) { const int xi = 8 * (i >> 2) + (i & 3); s[kb][i] = (32 * kb + xi + k0 >= 0) ? s[kb][i] : -3.0e38f; }
        }
    }
    float mx = -3.0e38f;
#pragma unroll
    for (int kb = 0; kb < 5; ++kb)
#pragma unroll
        for (int i = 0; i < 16; i += 2) mx = fmaxf(mx, fmaxf(s[kb][i], s[kb][i + 1]));
    mx = half_swap_max(mx);
    float sum = 0.f;
#pragma unroll
    for (int kb = 0; kb < 5; ++kb)
#pragma unroll
        for (int i = 0; i < 16; ++i) { const float p = __builtin_amdgcn_exp2f(s[kb][i] - mx); s[kb][i] = p; sum += p; }
    sum = half_swap_sum(sum);
    f32x16 o[2];
#pragma unroll
    for (int i = 0; i < 16; ++i) { o[0][i] = 0.f; o[1][i] = 0.f; }
    const int gi = (lane >> 4) & 1, q4 = (lane >> 2) & 3, p4 = lane & 3;
    const LAS unsigned char* vbase = lds + LDS_V + (32 * w + 4 * hh + q4) * VSTR + (16 * gi + 4 * p4) * 2;
#pragma unroll
    for (int c = 0; c < 10; ++c) {
        const int kb = c >> 1, c2 = c & 1;
        u32x4 pw; pw.x = pk2(s[kb][8 * c2 + 0], s[kb][8 * c2 + 1]); pw.y = pk2(s[kb][8 * c2 + 2], s[kb][8 * c2 + 3]); pw.z = pk2(s[kb][8 * c2 + 4], s[kb][8 * c2 + 5]); pw.w = pk2(s[kb][8 * c2 + 6], s[kb][8 * c2 + 7]);
        const bf16x8 pb = __builtin_bit_cast(bf16x8, pw);
#pragma unroll
        for (int db = 0; db < 2; ++db) {
            const s16x4 lo = __builtin_bit_cast(s16x4, __builtin_amdgcn_ds_read_tr16_b64_v4i16((LAS s16x4*)(vbase + (16 * c) * VSTR + db * 64)));
            const s16x4 hi = __builtin_bit_cast(s16x4, __builtin_amdgcn_ds_read_tr16_b64_v4i16((LAS s16x4*)(vbase + (16 * c + 8) * VSTR + db * 64)));
            bf16x8 a; a[0] = lo[0]; a[1] = lo[1]; a[2] = lo[2]; a[3] = lo[3]; a[4] = hi[0]; a[5] = hi[1]; a[6] = hi[2]; a[7] = hi[3];
            o[db] = __builtin_amdgcn_mfma_f32_32x32x16_bf16(a, pb, o[db], 0, 0, 0);
        }
    }
    const float inv = 1.f / sum;
    bf16_t* op = OG + ((size_t)g * M + qrow) * D + h * 64;
#pragma unroll
    for (int db = 0; db < 2; ++db)
#pragma unroll
        for (int i4 = 0; i4 < 4; ++i4) {
            u32x2 ov; ov.x = pk2(o[db][4 * i4] * inv, o[db][4 * i4 + 1] * inv); ov.y = pk2(o[db][4 * i4 + 2] * inv, o[db][4 * i4 + 3] * inv);
            *(u32x2*)(op + 32 * db + 8 * i4 + 4 * hh) = ov;
        }
    if (hh == 0) LSE[((size_t)g * M + qrow) * 16 + h] = (mx + __builtin_amdgcn_logf(sum)) * LN2;
}
__device__ __forceinline__ void attn_sample_task(const Params& P, int task, int lane, LAS float* wl) {
    const bf16_t* QB = (const bf16_t*)(P.ws + WS_QB);
    bf16_t* OG = (bf16_t*)(P.ws + WS_OG); float* LSE = (float*)(P.ws + WS_LSE);
    const int t = task & 7, h = (task >> 3) & 15, g = (task >> 7) % 3, b = task / 384;
    const int Lb = 128 << (2 * g), r = 1 << (2 * g);
    const bf16_t* kc = (const bf16_t*)(P.ws + WS_KC) + (g == 0 ? 0 : (g == 1 ? KC_OFF1 : KC_OFF2)) + (size_t)b * (Lb + 8) * 2048 + h * 64;
    const size_t qrow = (size_t)MP + b * 8 + t, colbase = (size_t)g * 1024 + h * 64;
    LAS float* qs = wl; LAS float* ps = wl + 64;
    const unsigned qraw = (unsigned)QB[qrow * GH + colbase + lane];
    const int top = Lb + t;
    u32x4 k0[8], k1[8];
    { const u32x4* p0 = (const u32x4*)(kc + (size_t)(top - r * lane) * 2048); const u32x4* p1 = (const u32x4*)(kc + (size_t)(top - r * (lane + 64)) * 2048);
#pragma unroll
      for (int c = 0; c < 8; ++c) { k0[c] = p0[c]; k1[c] = p1[c]; } }
    const int dp = lane & 31, kp = lane >> 5;
    const bf16_t* vb = kc + 1024 + 2 * dp;
    unsigned vv[65];
#pragma unroll
    for (int e = 0; e < 65; ++e) { int j = 2 * e + kp; j = j > 128 ? 128 : j; vv[e] = *(const unsigned*)(vb + (size_t)(top - r * j) * 2048); }
    const unsigned kk128 = (unsigned)kc[(size_t)(top - r * 128) * 2048 + lane];
    qs[lane] = bflo(qraw);
    __builtin_amdgcn_wave_barrier();
    float sc0 = 0.f, sc1 = 0.f, sc2 = 0.f;
#pragma unroll
    for (int c = 0; c < 8; ++c) { const f32x4 qa = *(const LAS f32x4*)(qs + 8 * c), qb = *(const LAS f32x4*)(qs + 8 * c + 4);
        sc0 += qa[0] * bflo(k0[c].x) + qa[1] * bfhi(k0[c].x) + qa[2] * bflo(k0[c].y) + qa[3] * bfhi(k0[c].y) + qb[0] * bflo(k0[c].z) + qb[1] * bfhi(k0[c].z) + qb[2] * bflo(k0[c].w) + qb[3] * bfhi(k0[c].w);
        sc1 += qa[0] * bflo(k1[c].x) + qa[1] * bfhi(k1[c].x) + qa[2] * bflo(k1[c].y) + qa[3] * bfhi(k1[c].y) + qb[0] * bflo(k1[c].z) + qb[1] * bfhi(k1[c].z) + qb[2] * bflo(k1[c].w) + qb[3] * bfhi(k1[c].w); }
    sc2 = wave_sum_dpp(qs[lane] * bflo(kk128));
    const float mx = wave_max_dpp(fmaxf(fmaxf(sc0, sc1), sc2));
    const float p0 = __builtin_amdgcn_exp2f(sc0 - mx), p1 = __builtin_amdgcn_exp2f(sc1 - mx), p2 = __builtin_amdgcn_exp2f(sc2 - mx);
    const float sum = wave_sum_dpp(p0 + p1) + p2;
    ps[lane] = p0; ps[64 + lane] = p1; if (lane < 2) ps[128 + lane] = lane == 0 ? p2 : 0.f;
    __builtin_amdgcn_wave_barrier();
    float o0 = 0.f, o1 = 0.f;
#pragma unroll
    for (int e = 0; e < 65; ++e) { const float pj = ps[2 * e + kp]; o0 += pj * bflo(vv[e]); o1 += pj * bfhi(vv[e]); }
    o0 = half_swap_sum(o0); o1 = half_swap_sum(o1);
    const float inv = 1.f / sum;
    if (kp == 0) *(unsigned*)(OG + ((size_t)g * M + qrow) * D + h * 64 + 2 * dp) = pk2(o0 * inv, o1 * inv);
    if (lane == 0) LSE[((size_t)g * M + qrow) * 16 + h] = (mx + __builtin_amdgcn_logf(sum)) * LN2;
    __builtin_amdgcn_wave_barrier();
}
__device__ __forceinline__ void phase_attn(const Params& P, LAS unsigned char* lds) {
    const int tid = threadIdx.x, lane = tid & 63, wave = tid >> 6;
    const int gw = blockIdx.x * 8 + wave, NGW = gridDim.x * 8;
#ifndef SKIP_SAMPLE
    for (int rs_ = 0; rs_ < PROBE_ASM; ++rs_)
    for (int task = gw; task < DECB * 3 * 16 * DECT; task += NGW) attn_sample_task(P, task, lane, (LAS float*)(lds + wave * 1024));
#endif
    const bf16_t* QB = (const bf16_t*)(P.ws + WS_QB); const bf16_t* KB = (const bf16_t*)(P.ws + WS_KB); const bf16_t* VB = (const bf16_t*)(P.ws + WS_VB);
    bf16_t* OG = (bf16_t*)(P.ws + WS_OG); float* LSE = (float*)(P.ws + WS_LSE);
    __syncthreads();
#ifndef SKIP_PROMPT
    for (int rq_ = 0; rq_ < PROBE_APR; ++rq_) {
        AttnRegs R;
        int u = blockIdx.x;
        if (u < 3072) attn_prompt_load(u, R, QB, KB, VB);
        while (u < 3072) {
            const int un = u + gridDim.x;
            attn_prompt_stage(lds, R);
            bf16x8 qf[4];
#pragma unroll
            for (int ks = 0; ks < 4; ++ks) qf[ks] = R.qf[ks];
            __syncthreads();
            if (un < 3072) attn_prompt_load(un, R, QB, KB, VB);
            attn_prompt_compute(lds, u, qf, OG, LSE);
            __syncthreads();
            u = un;
        }
    }
#endif
}
__device__ __forceinline__ void phase_merge(const Params& P) {
    const bf16_t* OG = (const bf16_t*)(P.ws + WS_OG); const float* LSE = (const float*)(P.ws + WS_LSE); bf16_t* O = (bf16_t*)(P.ws + WS_HB);
    const size_t gt = (size_t)blockIdx.x * 512 + threadIdx.x, nthr = (size_t)gridDim.x * 512;
    constexpr size_t NIT = (size_t)M * 128;
    for (size_t it0 = gt; it0 < NIT; it0 += 4 * nthr) {
        float l[4][3]; u32x4 a[4], bq[4], c[4]; size_t off[4];
#pragma unroll
        for (int k = 0; k < 4; ++k) {
            size_t it = it0 + k * nthr; if (it >= NIT) it = it0;
            const size_t row = it >> 7; const int h = (int)(it >> 3) & 15, c8 = (int)it & 7;
            l[k][0] = LSE[row * 16 + h]; l[k][1] = LSE[((size_t)M + row) * 16 + h]; l[k][2] = LSE[((size_t)2 * M + row) * 16 + h];
            off[k] = row * D + h * 64 + c8 * 8;
            a[k] = *(const u32x4*)(OG + off[k]); bq[k] = *(const u32x4*)(OG + (size_t)M * D + off[k]); c[k] = *(const u32x4*)(OG + (size_t)2 * M * D + off[k]);
        }
#pragma unroll
        for (int k = 0; k < 4; ++k) {
            if (it0 + k * nthr >= NIT) continue;
            const float mx = fmaxf(l[k][0], fmaxf(l[k][1], l[k][2]));
            float w0 = __expf(l[k][0] - mx), w1 = __expf(l[k][1] - mx), w2 = __expf(l[k][2] - mx);
            const float inv = 1.f / (w0 + w1 + w2); w0 *= inv; w1 *= inv; w2 *= inv;
            u32x4 o;
            o.x = pk2(w0 * bflo(a[k].x) + w1 * bflo(bq[k].x) + w2 * bflo(c[k].x), w0 * bfhi(a[k].x) + w1 * bfhi(bq[k].x) + w2 * bfhi(c[k].x));
            o.y = pk2(w0 * bflo(a[k].y) + w1 * bflo(bq[k].y) + w2 * bflo(c[k].y), w0 * bfhi(a[k].y) + w1 * bfhi(bq[k].y) + w2 * bfhi(c[k].y));
            o.z = pk2(w0 * bflo(a[k].z) + w1 * bflo(bq[k].z) + w2 * bflo(c[k].z), w0 * bfhi(a[k].z) + w1 * bfhi(bq[k].z) + w2 * bfhi(c[k].z));
            o.w = pk2(w0 * bflo(a[k].w) + w1 * bflo(bq[k].w) + w2 * bflo(c[k].w), w0 * bfhi(a[k].w) + w1 * bfhi(bq[k].w) + w2 * bfhi(c[k].w));
            *(u32x4*)(O + off[k]) = o;
        }
    }
}


#define XB_XCNT(j)  (256  + 64 * (j))
#define XB_XSUB(j)  (1280 + 64 * (j))
#define XB_XGEN(j)  (2304 + 64 * (j))
#define XB_TOP      3328
#define XB_TOPGEN   3392
#define XB_COPY     3456
struct GridBar { unsigned* bar; unsigned x; volatile LAS unsigned* st; LAS unsigned char* lds; const Params* kp; };
__device__ __forceinline__ GridBar grid_bar_post(unsigned* bar, volatile LAS unsigned* st) {
    GridBar b; b.bar = bar; b.x = xb_xcc_id(); b.st = st; b.lds = nullptr; b.kp = nullptr;
    if (threadIdx.x == 0) (void)xb_add(&bar[XB_XCNT(b.x)], 1u);
    return b;
}
__device__ __forceinline__ void grid_barrier(const GridBar& b, const Params& P, bool& copy_left) {
    asm volatile("s_waitcnt vmcnt(0)" ::: "memory");
    __syncthreads();
    unsigned gen = 0u, tg = 0u; bool leader = false;
    unsigned* bar = b.bar;
    if (threadIdx.x == 0) {
        __builtin_amdgcn_s_waitcnt(0);
        unsigned nloc = b.st[0], nx = b.st[1];
        if (nloc == 0u) {
            const unsigned G = gridDim.x; unsigned sp = 0u;
            for (;;) { unsigned sum = 0u, cnt = 0u, mine = 0u;
#pragma unroll
                for (unsigned j = 0; j < 16; ++j) { const unsigned c = xb_ld(&bar[XB_XCNT(j)]); sum += c; cnt += (c > 0u) ? 1u : 0u; mine = (j == b.x) ? c : mine; }
                nloc = mine > 0u ? mine : 1u; nx = cnt > 0u ? cnt : 1u;
                if (sum == G || ++sp > (1u << 22)) break;
                __builtin_amdgcn_s_sleep(1); }
            b.st[0] = nloc; b.st[1] = nx;
        }
        const unsigned old = xb_add(&bar[XB_XSUB(b.x)], 1u);
        gen = old / nloc;
        if (old + 1u == (gen + 1u) * nloc) {
            leader = true;
            __builtin_amdgcn_fence(__ATOMIC_RELEASE, "agent");
            asm volatile("s_waitcnt vmcnt(0)" ::: "memory");
            const unsigned og = xb_add(&bar[XB_TOP], 1u);
            tg = og / nx;
            if (og + 1u == (tg + 1u) * nx) xb_add(&bar[XB_TOPGEN], 1u);
        }
    }
    unsigned spins = 0u;
    for (;;) {
        if (threadIdx.x == 0) {
            const bool done = leader ? (xb_ld(&bar[XB_TOPGEN]) != tg) : (xb_ld(&bar[XB_XGEN(b.x)]) != gen);
            b.st[2] = (done || ++spins > (1u << 24)) ? 1u : 0u;
            if (!done && copy_left) b.st[3] = xb_add(&bar[XB_COPY], 1u);
        }
        __syncthreads();
        const unsigned d = b.st[2], c = b.st[3];
        __syncthreads();
        if (d) break;
        if (copy_left) { if (c < QTOT) work_item(b.kp, c, b.lds); else copy_left = false; }
        else __builtin_amdgcn_s_sleep(2);
    }
    if (threadIdx.x == 0) {
        __builtin_amdgcn_fence(__ATOMIC_ACQUIRE, "agent");
        if (leader) xb_add(&bar[XB_XGEN(b.x)], 1u);
        asm volatile("s_waitcnt vmcnt(0)" ::: "memory");
    }
    __syncthreads();
}
__device__ __forceinline__ void work_drain(const GridBar& b, const Params& P, bool& copy_left, unsigned wm) {
    while (copy_left) {
        if (threadIdx.x == 0) { const unsigned cur = xb_ld(&b.bar[XB_COPY]); b.st[3] = cur >= wm ? 0xffffffffu : xb_add(&b.bar[XB_COPY], 1u); }
        __syncthreads();
        const unsigned c = b.st[3];
        __syncthreads();
        if (c == 0xffffffffu) break;
        if (c < QTOT) work_item(b.kp, c, b.lds); else copy_left = false;
    }
}

template <int K>
__device__ __forceinline__ void skinny_res(LAS unsigned char* lds, const bf16_t* A, const bf16_t* Bt, const float* xold, float* xnew, bf16_t* xb, const float* bias, float* ss_out) {
    const int tid = threadIdx.x, lane = tid & 63, w = tid >> 6, l32 = lane & 31, hh = lane >> 5;
    const int c = blockIdx.x; if (c >= 256) return;
    const int r0 = MP + 32 * (c >> 5), c0 = 32 * (c & 31);
    constexpr int KW = K / 8, NS = KW / 16;
    const bf16_t* ap = A + (size_t)(r0 + l32) * K + w * KW + 8 * hh;
    const bf16_t* bp = Bt + (size_t)(c0 + l32) * K + w * KW + 8 * hh;
    float xo2[2], bs = bias ? bias[c0 + l32] : 0.f;
#pragma unroll
    for (int ii = 0; ii < 2; ++ii) { const int i = 2 * w + ii; xo2[ii] = xold[(size_t)(r0 - MP + 8 * (i >> 2) + 4 * hh + (i & 3)) * D + c0 + l32]; }
    f32x16 acc;
#pragma unroll
    for (int i = 0; i < 16; ++i) acc[i] = 0.f;
    constexpr int BATCHN = NS > 11 ? 11 : NS;
#pragma unroll
    for (int s0 = 0; s0 < NS; s0 += BATCHN) {
        bf16x8 av[BATCHN], bv[BATCHN];
#pragma unroll
        for (int s = 0; s < BATCHN; ++s) { av[s] = *(const bf16x8*)(ap + 16 * (s0 + s)); bv[s] = *(const bf16x8*)(bp + 16 * (s0 + s)); }
#pragma unroll
        for (int s = 0; s < BATCHN; ++s) acc = __builtin_amdgcn_mfma_f32_32x32x16_bf16(av[s], bv[s], acc, 0, 0, 0);
    }
    LAS float* red = (LAS float*)lds;
#pragma unroll
    for (int i = 0; i < 16; ++i) red[(w * 16 + i) * 64 + lane] = acc[i];
    __syncthreads();
#pragma unroll
    for (int ii = 0; ii < 2; ++ii) {
        const int i = 2 * w + ii;
        float v = 0.f;
#pragma unroll
        for (int ww = 0; ww < 8; ++ww) v += red[(ww * 16 + i) * 64 + lane];
        const int row = r0 + 8 * (i >> 2) + 4 * hh + (i & 3), col = c0 + l32;
        const float x = xo2[ii] + v + bs;
        xnew[(size_t)row * D + col] = x;
        xb[(size_t)row * D + col] = (bf16_t)(pk2(x, 0.f) & 0xffffu);
        float sq = x * x;
#pragma unroll
        for (int o = 1; o < 32; o <<= 1) sq += __shfl_xor(sq, o);
        if (ss_out && l32 == 0) atomicAdd(ss_out + row, sq);
    }
    __syncthreads();
}

__global__ void __launch_bounds__(512, 2) mega_fwd(Params P) {
    extern __shared__ __attribute__((aligned(16))) unsigned char lds_raw[];
    LAS unsigned char* lds = (LAS unsigned char*)lds_raw;
    unsigned char* ws = P.ws;
    const int lo = P.ph_lo, hi = P.ph_hi;
    float* SS = (float*)(ws + WS_CTL + SS_OFF);
    bf16_t* XB = (bf16_t*)(ws + WS_XB); bf16_t* GLU = (bf16_t*)(ws + WS_GLU); bf16_t* HB = (bf16_t*)(ws + WS_HB); bf16_t* ACT = (bf16_t*)(ws + WS_ACT);
    bf16_t* QB = (bf16_t*)(ws + WS_QB); bf16_t* KB = (bf16_t*)(ws + WS_KB); bf16_t* VB = (bf16_t*)(ws + WS_VB);
#define IN(k) (lo <= (k) && (k) < hi)
#if ONE_LAUNCH
    volatile LAS unsigned* st = (volatile LAS unsigned*)(lds + 131072);
    if (threadIdx.x < 4) st[threadIdx.x] = 0u;
    __syncthreads();
    GridBar gb = grid_bar_post((unsigned*)(ws + WS_CTL), st); gb.lds = lds; gb.kp = (const Params*)__builtin_amdgcn_kernarg_segment_ptr();
    bool copy_left = true;
#define SEAM(k) do { if ((k) + 1 < hi) { if ((k) == 0) cg::this_grid().sync(); else { if (work_need((k) + 1) > work_need((k))) work_drain(gb, P, copy_left, work_need((k) + 1)); grid_barrier(gb, P, copy_left); } } } while (0)
#else
#define SEAM(k) do { } while (0)
#endif
#ifdef SKIP_GEMM
#define GEMM(EpiT, E, Aptr, Bptr, N_, K_, GP_) do { } while (0)
#else
#define GEMM(EpiT, E, Aptr, Bptr, N_, K_, GP_) do { pg8::Gemm g_{(Aptr), (Bptr), M, (N_), (K_)}; pg8::StaticOrder S_; S_.init(M, (N_), (ONE_LAUNCH && (int)gridDim.x == 256) ? (GP_) : (int)gridDim.x, (int)blockIdx.x); pg8::gemm_phase<EpiT>(lds, g_, S_, (E)); } while (0)
#endif
#define RESGEMM(E, Aptr, Bptr, K_) do { skinny_res<(K_)>(lds, (Aptr), (Bptr), (E).xold_s, (E).xnew, (E).xb, (E).bias, (E).ss_out); \
        pg8::Gemm g_{(Aptr), (Bptr), MP, D, (K_)}; pg8::StaticOrder S_; S_.init(MP, D, (int)gridDim.x, (int)blockIdx.x); pg8::gemm_phase<EpiRes>(lds, g_, S_, (E)); } while (0)
    #ifndef SKIP_PRO
    if (IN(0)) { for (int rp_ = 0; rp_ < PROBE_PR; ++rp_) phase_prologue(P, lds); SEAM(0); }
#endif
#define CONV_LAYER(l, p0) \
    if (IN((p0))) { EpiGLU E{GLU, SS + (size_t)(2 * (l)) * M, P.in[8] + (l) * 2 * D, P.out + O_CP + (size_t)(l) * 4 * 30 * D, P.out + O_CS + (size_t)(l) * 32 * 30 * D}; \
        for (int rw_ = 0; rw_ < PROBE_WIN; ++rw_) { GEMM(EpiGLU, E, XB, (const bf16_t*)(ws + WS_WIN) + (size_t)(l) * 2 * D * D, 2 * D, D, 176); } SEAM((p0)); } \
    if (IN((p0) + 1)) { for (int rp_ = 0; rp_ < PROBE_CV; ++rp_) phase_conv(P, lds, (l)); SEAM((p0) + 1); } \
    if (IN((p0) + 2)) { EpiRes E{(l) == 0 ? P.in[0] : P.out, (l) == 0 ? P.in[1] : P.out + (size_t)MP * D, P.out, XB, P.in[14] + (l) * D, SS + (size_t)(2 * (l) + 1) * M}; \
        RESGEMM(E, HB, (const bf16_t*)(ws + WS_WOUT) + (size_t)(l) * D * D, D); SEAM((p0) + 2); } \
    if (IN((p0) + 3)) { EpiSwiGLU E{ACT, SS + (size_t)(2 * (l) + 1) * M}; \
        for (int rp_ = 0; rp_ < ((l) == 0 ? PROBE_GU : 1); ++rp_) { GEMM(EpiSwiGLU, E, XB, (const bf16_t*)(ws + WS_WGU) + (size_t)(l) * 2 * FF * D, 2 * FF, D, 240); } SEAM((p0) + 3); } \
    if (IN((p0) + 4)) { EpiRes E{P.out, P.out + (size_t)MP * D, P.out, XB, nullptr, SS + (size_t)(2 * (l) + 2) * M}; \
        if (PROBE_DN && (l) == 0) { EpiRes E2 = E; E2.xnew = (float*)(ws + 1100 * MiB) - (size_t)0; E2.xb = (bf16_t*)(ws + 1200 * MiB); E2.ss_out = (float*)(ws + 1300 * MiB); RESGEMM(E2, ACT, (const bf16_t*)(ws + WS_WDN) + (size_t)(l) * D * FF, FF); } \
        RESGEMM(E, ACT, (const bf16_t*)(ws + WS_WDN) + (size_t)(l) * D * FF, FF); SEAM((p0) + 4); }
    CONV_LAYER(0, 1)
    CONV_LAYER(1, 6)
#define ATTN_LAYER(j, l, p0, WQPTR, NQ) \
    if (IN((p0))) { EpiQKV<j> E{ws, P.in[17], P.in[20] + (j) * 3 * 64, P.out}; \
        for (int rq_ = 0; rq_ < ((j) == 0 ? PROBE_QKV : 1); ++rq_) { GEMM(EpiQKV<j>, E, XB, (const bf16_t*)(ws + (WQPTR)), (NQ), D, (j) == 0 ? 240 : 200); } SEAM((p0)); } \
    if (IN((p0) + 1)) { for (int rp_ = 0; rp_ < PROBE_AT; ++rp_) phase_attn(P, lds); SEAM((p0) + 1); } \
    if (IN((p0) + 2)) { for (int rm_ = 0; rm_ < PROBE_MG; ++rm_) phase_merge(P); SEAM((p0) + 2); } \
    if (IN((p0) + 3)) { EpiRes E{P.out, P.out + (size_t)MP * D, P.out, XB, nullptr, SS + (size_t)(2 * (l) + 1) * M}; \
        RESGEMM(E, HB, (const bf16_t*)(ws + WS_WO) + (size_t)(j) * D * D, D); SEAM((p0) + 3); } \
    if (IN((p0) + 4)) { EpiSwiGLU E{ACT, SS + (size_t)(2 * (l) + 1) * M}; \
        GEMM(EpiSwiGLU, E, XB, (const bf16_t*)(ws + WS_WGU) + (size_t)(l) * 2 * FF * D, 2 * FF, D, 240); SEAM((p0) + 4); } \
    if (IN((p0) + 5)) { EpiRes E{P.out, P.out + (size_t)MP * D, P.out, XB, nullptr, (l) == 3 ? nullptr : SS + (size_t)(2 * (l) + 2) * M}; \
        RESGEMM(E, ACT, (const bf16_t*)(ws + WS_WDN) + (size_t)(l) * D * FF, FF); SEAM((p0) + 5); }
    ATTN_LAYER(0, 2, 11, WS_WQKV, 9216)
    ATTN_LAYER(1, 3, 17, WS_WQ2, GH)
#undef CONV_LAYER
#undef ATTN_LAYER
#if ONE_LAUNCH
    work_drain(gb, P, copy_left, QTOT);
#endif
#undef IN
#undef SEAM
#undef GEMM
#undef RESGEMM
}

extern "C" void kernel_launch(void* const* d_in, const int* in_sizes, int n_in, void* d_out, int out_size, void* d_ws, size_t ws_size, hipStream_t stream) {
    static int grid = 0;
    if (grid == 0) {
        if (n_in != 25 || (size_t)out_size != O_END || ws_size < WS_END) { fprintf(stderr, "kernel_launch: unexpected shapes (n_in %d, out %d, ws %zu)\n", n_in, out_size, ws_size); grid = -1; return; }
        int dev = 0, cus = 0, per_cu = 0;
        hipGetDevice(&dev); hipDeviceGetAttribute(&cus, hipDeviceAttributeMultiprocessorCount, dev);
        hipFuncSetAttribute((const void*)mega_fwd, hipFuncAttributeMaxDynamicSharedMemorySize, LDS_BYTES);
        hipOccupancyMaxActiveBlocksPerMultiprocessor(&per_cu, (const void*)mega_fwd, 512, LDS_BYTES);
        if (per_cu < 1) { fprintf(stderr, "kernel_launch: occupancy query says %d blocks/CU\n", per_cu); per_cu = 1; }
        (void)hipGetLastError();
        grid = cus;
    }
    if (grid < 0) return;
    hipMemsetAsync((char*)d_ws + WS_CTL, 0, CTL_BYTES, stream);
    Params p{};
    for (int i = 0; i < 25; ++i) p.in[i] = (const float*)d_in[i];
    p.out = (float*)d_out; p.ws = (unsigned char*)d_ws;
#if ONE_LAUNCH
    p.ph_lo = 0; p.ph_hi = NPH;
    void* args[] = {&p};
    hipError_t e = hipLaunchCooperativeKernel((const void*)mega_fwd, dim3(grid), dim3(512), args, LDS_BYTES, stream);
    if (e != hipSuccess) fprintf(stderr, "cooperative launch failed: %s (grid %d)\n", hipGetErrorString(e), grid);
#else
    for (int k = 0; k < NPH; ++k) { p.ph_lo = k; p.ph_hi = k + 1; hipLaunchKernelGGL(mega_fwd, dim3(grid), dim3(512), LDS_BYTES, stream, p); }
#endif
}
```
